# Optimizing an MI355X kernel written in HIP

```python
import jax, jax.numpy as jnp
from jax import lax
import numpy as np

D_MODEL = 1024
BATCH = 8
SEQ = 2048
DEPTH = 4

N_MIXERS = 3
N_SUB = 3
FFN_RES_WEIGHT = 0.5
D_FF = 2816
RMS_EPS = 1e-6
FOX_HEADS = 16
FOX_HEAD_DIM = D_MODEL // FOX_HEADS
FOX_BLOCK = 128
SCONV_WIDTH = 3
LRU_WIDTH = D_MODEL
LRU_BLOCKS = 16
LRU_BLOCK_DIM = LRU_WIDTH // LRU_BLOCKS
LRU_CONV_WIDTH = 4
LRU_C = 8.0
N_FOX = len(range(0, DEPTH, N_MIXERS))
N_SCONV = len(range(1, DEPTH, N_MIXERS))
N_LRU = len(range(2, DEPTH, N_MIXERS))

kernel_name = "hybrid_fox_shortconv_rglru_macaron"


def rmsnorm(x, g):
    x32 = x.astype(jnp.float32)
    y = x32 * lax.rsqrt(jnp.mean(x32 * x32, axis=-1, keepdims=True) + RMS_EPS)
    return y.astype(x.dtype) * g


def causal_depthwise_conv(u, w, b=None):
    k_w, ch = w.shape
    out = lax.conv_general_dilated(
        u, w[:, None, :].astype(u.dtype), window_strides=(1,),
        padding=[(k_w - 1, 0)], dimension_numbers=("NWC", "WIO", "NWC"),
        feature_group_count=ch)
    if b is not None:
        out = out + b
    return out


def swiglu(h, w_in, w_out):
    g, u = jnp.split(h @ w_in, 2, axis=-1)
    return (jax.nn.silu(g) * u) @ w_out


def fox_mixer(h, w_in, b_f, w_out):
    bsz, seq, _ = h.shape
    proj = h @ w_in
    q, k, v, f_logit = jnp.split(proj, [D_MODEL, 2 * D_MODEL, 3 * D_MODEL], axis=-1)
    q = q.reshape(bsz, seq, FOX_HEADS, FOX_HEAD_DIM)
    k = k.reshape(bsz, seq, FOX_HEADS, FOX_HEAD_DIM)
    v = v.reshape(bsz, seq, FOX_HEADS, FOX_HEAD_DIM)
    log_f = jax.nn.log_sigmoid((f_logit + b_f).astype(jnp.float32))
    cum = jnp.cumsum(log_f, axis=1).transpose(0, 2, 1)
    scale = FOX_HEAD_DIM ** -0.5
    outs = []
    for blk in range(seq // FOX_BLOCK):
        s0 = blk * FOX_BLOCK
        s1 = s0 + FOX_BLOCK
        logits = jnp.einsum("bqhd,bkhd->bhqk", q[:, s0:s1], k[:, :s1]).astype(jnp.float32) * scale
        logits = logits + cum[:, :, s0:s1, None] - cum[:, :, None, :s1]
        q_pos = jnp.arange(s0, s1)[:, None]
        k_pos = jnp.arange(s1)[None, :]
        logits = jnp.where(k_pos <= q_pos, logits, -jnp.inf)
        p = jax.nn.softmax(logits, axis=-1).astype(v.dtype)
        outs.append(jnp.einsum("bhqk,bkhd->bqhd", p, v[:, :s1]))
    o = jnp.concatenate(outs, axis=1).reshape(bsz, seq, D_MODEL)
    return o @ w_out


def sconv_mixer(h, w_in, conv_w, w_out):
    b_gate, c_gate, xv = jnp.split(h @ w_in, 3, axis=-1)
    y = b_gate * causal_depthwise_conv(c_gate * xv, conv_w)
    return y @ w_out


def lru_mixer(h, w_in, conv_w, conv_b, w_a, b_a, w_x, b_x, lam, w_out):
    bsz, seq, _ = h.shape
    gate, xb = jnp.split(h @ w_in, 2, axis=-1)
    xb = causal_depthwise_conv(xb, conv_w, conv_b)
    xh = xb.reshape(bsz, seq, LRU_BLOCKS, LRU_BLOCK_DIM)
    r = jax.nn.sigmoid(jnp.einsum("bsni,nij->bsnj", xh, w_a) + b_a).reshape(bsz, seq, LRU_WIDTH)
    i = jax.nn.sigmoid(jnp.einsum("bsni,nij->bsnj", xh, w_x) + b_x).reshape(bsz, seq, LRU_WIDTH)
    log_a = -LRU_C * r.astype(jnp.float32) * jax.nn.softplus(-lam.astype(jnp.float32))
    a = jnp.exp(log_a)
    mult = jnp.sqrt(-jnp.expm1(2.0 * log_a))
    b_term = mult * (i * xb).astype(jnp.float32)

    def combine(left, right):
        a1, b1 = left
        a2, b2 = right
        return a1 * a2, a2 * b1 + b2

    _, hs = lax.associative_scan(combine, (a, b_term), axis=1)
    y = hs.astype(h.dtype) * jax.nn.gelu(gate)
    return y @ w_out


def setup_inputs(seed: int = 0) -> dict:
    key = jax.random.key(seed)
    ks = jax.random.split(key, 24)
    f32 = jnp.float32

    def nrm(k, shape, fan_in):
        return jax.random.normal(k, shape, f32) * (fan_in ** -0.5)

    x = jax.random.normal(ks[0], (BATCH, SEQ, D_MODEL), f32)
    c = jax.random.normal(ks[1], (BATCH, D_MODEL), f32)
    w_cond = nrm(ks[2], (DEPTH, D_MODEL, N_SUB * 3 * D_MODEL), D_MODEL)
    b_cond = 0.02 * jax.random.normal(ks[3], (DEPTH, N_SUB * 3 * D_MODEL), f32)
    norm_pre = 1.0 + 0.05 * jax.random.normal(ks[4], (DEPTH, N_SUB, D_MODEL), f32)
    norm_post = 1.0 + 0.05 * jax.random.normal(ks[5], (DEPTH, N_SUB, D_MODEL), f32)
    w_ffn_in = nrm(ks[6], (DEPTH, 2, D_MODEL, 2 * D_FF), D_MODEL)
    w_ffn_out = nrm(ks[7], (DEPTH, 2, D_FF, D_MODEL), D_FF)
    fox_w_in = nrm(ks[8], (N_FOX, D_MODEL, 3 * D_MODEL + FOX_HEADS), D_MODEL)
    fox_b_f = jax.random.uniform(ks[9], (N_FOX, FOX_HEADS), f32, 1.0, 4.0)
    fox_w_out = nrm(ks[10], (N_FOX, D_MODEL, D_MODEL), D_MODEL)
    sconv_w_in = nrm(ks[11], (N_SCONV, D_MODEL, 3 * D_MODEL), D_MODEL)
    sconv_conv_w = nrm(ks[12], (N_SCONV, SCONV_WIDTH, D_MODEL), SCONV_WIDTH)
    sconv_w_out = nrm(ks[13], (N_SCONV, D_MODEL, D_MODEL), D_MODEL)
    lru_w_in = nrm(ks[14], (N_LRU, D_MODEL, 2 * LRU_WIDTH), D_MODEL)
    lru_conv_w = nrm(ks[15], (N_LRU, LRU_CONV_WIDTH, LRU_WIDTH), LRU_CONV_WIDTH)
    lru_conv_b = 0.02 * jax.random.normal(ks[16], (N_LRU, LRU_WIDTH), f32)
    lru_w_a = nrm(ks[17], (N_LRU, LRU_BLOCKS, LRU_BLOCK_DIM, LRU_BLOCK_DIM), LRU_BLOCK_DIM)
    lru_b_a = 0.02 * jax.random.normal(ks[18], (N_LRU, LRU_BLOCKS, LRU_BLOCK_DIM), f32)
    lru_w_x = nrm(ks[19], (N_LRU, LRU_BLOCKS, LRU_BLOCK_DIM, LRU_BLOCK_DIM), LRU_BLOCK_DIM)
    lru_b_x = 0.02 * jax.random.normal(ks[20], (N_LRU, LRU_BLOCKS, LRU_BLOCK_DIM), f32)
    a_c = jax.random.uniform(ks[21], (N_LRU, LRU_WIDTH), f32, 0.9, 0.999)
    s = a_c ** (1.0 / LRU_C)
    lru_lambda = jnp.log(s) - jnp.log1p(-s)
    lru_w_out = nrm(ks[22], (N_LRU, LRU_WIDTH, D_MODEL), LRU_WIDTH)
    return {
        "x": x, "c": c, "w_cond": w_cond, "b_cond": b_cond,
        "norm_pre": norm_pre, "norm_post": norm_post,
        "w_ffn_in": w_ffn_in, "w_ffn_out": w_ffn_out,
        "fox_w_in": fox_w_in, "fox_b_f": fox_b_f, "fox_w_out": fox_w_out,
        "sconv_w_in": sconv_w_in, "sconv_conv_w": sconv_conv_w, "sconv_w_out": sconv_w_out,
        "lru_w_in": lru_w_in, "lru_conv_w": lru_conv_w, "lru_conv_b": lru_conv_b,
        "lru_w_a": lru_w_a, "lru_b_a": lru_b_a, "lru_w_x": lru_w_x, "lru_b_x": lru_b_x,
        "lru_lambda": lru_lambda, "lru_w_out": lru_w_out,
    }


def reference(x, c, w_cond, b_cond, norm_pre, norm_post, w_ffn_in, w_ffn_out,
              fox_w_in, fox_b_f, fox_w_out, sconv_w_in, sconv_conv_w, sconv_w_out,
              lru_w_in, lru_conv_w, lru_conv_b, lru_w_a, lru_b_a, lru_w_x, lru_b_x,
              lru_lambda, lru_w_out):
    bsz = x.shape[0]
    c_act = jax.nn.silu(c)
    for i in range(DEPTH):
        mod = (c_act @ w_cond[i] + b_cond[i]).reshape(bsz, N_SUB, 3, D_MODEL)
        shift = mod[:, :, 0, None, :]
        scale = mod[:, :, 1, None, :]
        gate = mod[:, :, 2, None, :]

        def pre(h, s):
            return rmsnorm(h, norm_pre[i, s]) * (1.0 + scale[:, s]) + shift[:, s]

        y = swiglu(pre(x, 0), w_ffn_in[i, 0], w_ffn_out[i, 0])
        x = x + FFN_RES_WEIGHT * gate[:, 0] * rmsnorm(y, norm_post[i, 0])

        h = pre(x, 1)
        kind = i % N_MIXERS
        j = i // N_MIXERS
        if kind == 0:
            y = fox_mixer(h, fox_w_in[j], fox_b_f[j], fox_w_out[j])
        elif kind == 1:
            y = sconv_mixer(h, sconv_w_in[j], sconv_conv_w[j], sconv_w_out[j])
        else:
            y = lru_mixer(h, lru_w_in[j], lru_conv_w[j], lru_conv_b[j], lru_w_a[j], lru_b_a[j],
                          lru_w_x[j], lru_b_x[j], lru_lambda[j], lru_w_out[j])
        x = x + gate[:, 1] * rmsnorm(y, norm_post[i, 1])

        y = swiglu(pre(x, 2), w_ffn_in[i, 1], w_ffn_out[i, 1])
        x = x + FFN_RES_WEIGHT * gate[:, 2] * rmsnorm(y, norm_post[i, 2])
    return x
```

```cpp
#include <hip/hip_runtime.h>
#include <hip/hip_cooperative_groups.h>
#include <cstdio>
#include <cstdint>
namespace cg = cooperative_groups;

#define LAS __attribute__((address_space(3)))
typedef unsigned short bf16_t;
typedef short bf16x8 __attribute__((ext_vector_type(8)));
typedef short s16x4 __attribute__((ext_vector_type(4)));
typedef float f32x4 __attribute__((ext_vector_type(4)));
typedef float f32x16 __attribute__((ext_vector_type(16)));
typedef unsigned u32x4 __attribute__((ext_vector_type(4)));
typedef unsigned u32x2 __attribute__((ext_vector_type(2)));

constexpr int D = 1024, NB = 8, SEQ = 2048, M = NB * SEQ, FF = 2816, NLAYER = 4, MODW = 9216;
constexpr int NWAVES = 8, NTHR = 512;
constexpr int LDS_BYTES = 147456;
constexpr int NPH = 42;
constexpr float RMS_EPS = 1e-6f;
constexpr float L2E = 1.4426950408889634f;

constexpr size_t MiB = 1u << 20;
constexpr size_t WS_MOD = 0;
constexpr size_t WS_FL = 2 * MiB;
constexpr size_t WS_WFI = 4 * MiB;
constexpr size_t WS_WFO = 92 * MiB;
constexpr size_t WS_FOXI = 136 * MiB;
constexpr size_t WS_FOXO = 149 * MiB;
constexpr size_t WS_SCI = 153 * MiB;
constexpr size_t WS_SCO = 159 * MiB;
constexpr size_t WS_LRI = 161 * MiB;
constexpr size_t WS_LRO = 165 * MiB;
constexpr size_t WS_XN = 168 * MiB;
constexpr size_t WS_U = 200 * MiB;
constexpr size_t WS_Y = 232 * MiB;
constexpr size_t WS_P = 296 * MiB;
constexpr size_t WS_END = 392 * MiB;

struct Params { const float* in[23]; float* out; unsigned char* ws; int ph_lo, ph_hi; };

__device__ __forceinline__ unsigned f2bf(float f) { unsigned u = __builtin_bit_cast(unsigned, f); return (u + 0x7fffu + ((u >> 16) & 1u)) >> 16; }
__device__ __forceinline__ unsigned pk2(float lo, float hi) { return f2bf(lo) | (f2bf(hi) << 16); }
__device__ __forceinline__ float bf2f(unsigned h) { return __uint_as_float(h << 16); }
__device__ __forceinline__ int crow(int r, int hi) { return (r & 3) + 8 * (r >> 2) + 4 * hi; }
__device__ __forceinline__ float wave_sum(float v) {
#pragma unroll
    for (int o = 1; o < 64; o <<= 1) v += __shfl_xor(v, o);
    return v;
}
#define LDS_WAIT() asm volatile("s_waitcnt lgkmcnt(0)" ::: "memory")

__device__ __forceinline__ void transpose_item(const float* W, int ld, int K, bf16_t* WT, int k0, int n0, int dst_row0, LAS float* scr, int lane) {
#pragma unroll 8
    for (int i = 0; i < 32; ++i) { const int kk = 2 * i + (lane >> 5); scr[kk * 33 + (lane & 31)] = W[(size_t)(k0 + kk) * ld + n0 + (lane & 31)]; }
    LDS_WAIT(); asm volatile("" ::: "memory");
    const int c = lane & 7;
#pragma unroll
    for (int j = 0; j < 4; ++j) { const int n = (lane >> 3) + 8 * j; const LAS float* s = scr + (8 * c) * 33 + n;
        u32x4 o; o.x = pk2(s[0 * 33], s[1 * 33]); o.y = pk2(s[2 * 33], s[3 * 33]); o.z = pk2(s[4 * 33], s[5 * 33]); o.w = pk2(s[6 * 33], s[7 * 33]);
        *(u32x4*)(WT + (size_t)(dst_row0 + n) * K + k0 + 8 * c) = o; }
    LDS_WAIT(); asm volatile("" ::: "memory");
}
__device__ __forceinline__ void transpose_matrix_item(const float* W, int ld, int K, int N, bf16_t* WT, int mode, int item, LAS float* scr, int lane) {
    const int nblk = N / 32, kb = item / nblk, nb = item % nblk, n0 = 32 * nb;
    int dr = n0;
    if (mode == 1) { if (n0 < FF) dr = (n0 >> 7) * 256 + (n0 & 127); else { const int j = n0 - FF; dr = (j >> 7) * 256 + 128 + (j & 127); } }
    transpose_item(W, ld, K, WT, 64 * kb, n0, dr, scr, lane);
}

__device__ __forceinline__ void prologue_phase(const Params& p, LAS unsigned char* lds, int tid, int lane, int wave) {
    unsigned char* ws = p.ws;
    LAS float* cact = (LAS float*)lds;
    LAS float* part = (LAS float*)(lds + 32768);
    for (int i = tid; i < NB * D; i += NTHR) { const float v = p.in[1][i]; cact[i] = v / (1.f + __expf(-v)); }
    __syncthreads();
    float* MOD = (float*)(ws + WS_MOD);
    for (int task = blockIdx.x; task < NLAYER * MODW / 64; task += gridDim.x) {
        const int gc = task * 64, li = gc / MODW, n0 = gc % MODW;
        const float* W = p.in[2] + (size_t)li * D * MODW + n0 + lane;
        float acc[NB];
#pragma unroll
        for (int b = 0; b < NB; ++b) acc[b] = 0.f;
        const int kbeg = wave * 128;
#pragma unroll 8
        for (int k = 0; k < 128; ++k) { const float w = W[(size_t)(kbeg + k) * MODW];
#pragma unroll
            for (int b = 0; b < NB; ++b) acc[b] += w * cact[b * D + kbeg + k]; }
#pragma unroll
        for (int b = 0; b < NB; ++b) part[(wave * NB + b) * 64 + lane] = acc[b];
        __syncthreads();
        { const int b = tid >> 6; float s = 0.f;
#pragma unroll
          for (int w = 0; w < NWAVES; ++w) s += part[(w * NB + b) * 64 + lane];
          MOD[(size_t)(li * NB + b) * MODW + n0 + lane] = s + p.in[3][li * MODW + n0 + lane]; }
        __syncthreads();
    }
    LAS float* scr = (LAS float*)(lds + 49152 + wave * 8448);
    const int gw = blockIdx.x * NWAVES + wave, NGW = gridDim.x * NWAVES;
    constexpr int I_FI = 16 * 176, I_FO = 44 * 32, I_FXI = 16 * 96, I_SQ = 16 * 32, I_LRI = 16 * 64;
    constexpr int E0 = 8 * I_FI, E1 = E0 + 8 * I_FO, E2 = E1 + 2 * I_FXI, E3 = E2 + 2 * I_SQ, E4 = E3 + I_FXI, E5 = E4 + I_SQ, E6 = E5 + I_LRI, E7 = E6 + I_SQ;
    for (int it = gw; it < E7; it += NGW) {
        if (it < E0) { const int m = it / I_FI, r = it % I_FI; transpose_matrix_item(p.in[6] + (size_t)m * D * 2 * FF, 2 * FF, D, 2 * FF, (bf16_t*)(ws + WS_WFI) + (size_t)m * 2 * FF * D, 1, r, scr, lane); }
        else if (it < E1) { const int q = it - E0, m = q / I_FO, r = q % I_FO; transpose_matrix_item(p.in[7] + (size_t)m * FF * D, D, FF, D, (bf16_t*)(ws + WS_WFO) + (size_t)m * D * FF, 0, r, scr, lane); }
        else if (it < E2) { const int q = it - E1, m = q / I_FXI, r = q % I_FXI; transpose_matrix_item(p.in[8] + (size_t)m * D * 3088, 3088, D, 3072, (bf16_t*)(ws + WS_FOXI) + (size_t)m * 3328 * D, 0, r, scr, lane); }
        else if (it < E3) { const int q = it - E2, m = q / I_SQ, r = q % I_SQ; transpose_matrix_item(p.in[10] + (size_t)m * D * D, D, D, D, (bf16_t*)(ws + WS_FOXO) + (size_t)m * D * D, 0, r, scr, lane); }
        else if (it < E4) { transpose_matrix_item(p.in[11], 3072, D, 3072, (bf16_t*)(ws + WS_SCI), 0, it - E3, scr, lane); }
        else if (it < E5) { transpose_matrix_item(p.in[13], D, D, D, (bf16_t*)(ws + WS_SCO), 0, it - E4, scr, lane); }
        else if (it < E6) { transpose_matrix_item(p.in[14], 2048, D, 2048, (bf16_t*)(ws + WS_LRI), 0, it - E5, scr, lane); }
        else { transpose_matrix_item(p.in[22], D, D, D, (bf16_t*)(ws + WS_LRO), 0, it - E6, scr, lane); }
    }
    const int gt = blockIdx.x * NTHR + tid, NGT = gridDim.x * NTHR;
    for (int e = gt; e < 2 * 256 * 128; e += NGT) {
        const int m = e / (256 * 128), r = (e / 128) % 256, kc = e % 128;
        u32x4 o = (u32x4){0u, 0u, 0u, 0u};
        if (r < 16) { const float* W = p.in[8] + (size_t)m * D * 3088 + 3072 + r; const int k = kc * 8;
            o.x = pk2(W[(size_t)(k + 0) * 3088], W[(size_t)(k + 1) * 3088]); o.y = pk2(W[(size_t)(k + 2) * 3088], W[(size_t)(k + 3) * 3088]);
            o.z = pk2(W[(size_t)(k + 4) * 3088], W[(size_t)(k + 5) * 3088]); o.w = pk2(W[(size_t)(k + 6) * 3088], W[(size_t)(k + 7) * 3088]); }
        *(u32x4*)((bf16_t*)(ws + WS_FOXI) + (size_t)m * 3328 * D + (size_t)(3072 + r) * D + kc * 8) = o;
    }
}

__device__ __forceinline__ void thin_phase(const Params& p, int ip, int sp, int in_, int sn, const float* xin, int lane, int wave) {
    const float* MOD = (const float*)(p.ws + WS_MOD);
    const float* Y = (const float*)(p.ws + WS_Y);
    bf16_t* XN = (bf16_t*)(p.ws + WS_XN);
    const int gw = blockIdx.x * NWAVES + wave, NGW = gridDim.x * NWAVES;
    for (int m = gw; m < M; m += NGW) {
        const int b = m >> 11;
        f32x4 x[4];
#pragma unroll
        for (int j = 0; j < 4; ++j) x[j] = *(const f32x4*)(xin + (size_t)m * D + 4 * lane + 256 * j);
        if (ip >= 0) {
            f32x4 y[4]; float ss = 0.f;
#pragma unroll
            for (int j = 0; j < 4; ++j) { y[j] = *(const f32x4*)(Y + (size_t)m * D + 4 * lane + 256 * j); ss += (y[j].x * y[j].x + y[j].y * y[j].y) + (y[j].z * y[j].z + y[j].w * y[j].w); }
            const float rstd = rsqrtf(wave_sum(ss) * (1.f / D) + RMS_EPS) * (sp == 1 ? 1.0f : 0.5f);
            const float* gate = MOD + (size_t)(ip * NB + b) * MODW + sp * 3072 + 2048;
            const float* npost = p.in[5] + (ip * 3 + sp) * D;
#pragma unroll
            for (int j = 0; j < 4; ++j) { const f32x4 g = *(const f32x4*)(gate + 4 * lane + 256 * j), n = *(const f32x4*)(npost + 4 * lane + 256 * j); x[j] = x[j] + g * (y[j] * rstd) * n; }
        }
        if (ip >= 0 || xin != p.out) {
#pragma unroll
            for (int j = 0; j < 4; ++j) *(f32x4*)(p.out + (size_t)m * D + 4 * lane + 256 * j) = x[j];
        }
        if (in_ >= 0) {
            float ss = 0.f;
#pragma unroll
            for (int j = 0; j < 4; ++j) ss += (x[j].x * x[j].x + x[j].y * x[j].y) + (x[j].z * x[j].z + x[j].w * x[j].w);
            const float rstd = rsqrtf(wave_sum(ss) * (1.f / D) + RMS_EPS);
            const float* shift = MOD + (size_t)(in_ * NB + b) * MODW + sn * 3072;
            const float* scale = shift + 1024;
            const float* npre = p.in[4] + (in_ * 3 + sn) * D;
#pragma unroll
            for (int j = 0; j < 4; ++j) { const f32x4 sh = *(const f32x4*)(shift + 4 * lane + 256 * j), sc = *(const f32x4*)(scale + 4 * lane + 256 * j), n = *(const f32x4*)(npre + 4 * lane + 256 * j);
                const f32x4 v = (x[j] * rstd) * n * (sc + 1.0f) + sh;
                u32x2 o; o.x = pk2(v.x, v.y); o.y = pk2(v.z, v.w);
                *(u32x2*)(XN + (size_t)m * D + 4 * lane + 256 * j) = o; }
        }
    }
}

template <int EPI> __device__ __forceinline__ void gemm_simple(const bf16_t* A, const bf16_t* WT, int K, int N, float* Yo, bf16_t* Po, int ldp, float* FL, int lane, int wave) {
    const int r32 = lane & 31, hi = lane >> 5;
    const int gw = blockIdx.x * NWAVES + wave, NGW = gridDim.x * NWAVES;
    const int ntask = (M / 64) * (N / 64);
    for (int task = gw; task < ntask; task += NGW) {
        const int rb = task % (M / 64), cbk = task / (M / 64), row0 = rb * 64;
        int c0, c1;
        if (EPI == 1) { const int pn = cbk >> 2, q = cbk & 3; c0 = pn * 256 + 32 * q; c1 = c0 + 128; } else { c0 = cbk * 64; c1 = c0 + 32; }
        f32x16 acc[2][2];
#pragma unroll
        for (int i = 0; i < 2; ++i)
#pragma unroll
            for (int j = 0; j < 2; ++j)
#pragma unroll
                for (int r = 0; r < 16; ++r) acc[i][j][r] = 0.f;
        const bf16_t* a0 = A + (size_t)(row0 + r32) * K + 8 * hi; const bf16_t* a1 = a0 + (size_t)32 * K;
        const bf16_t* b0 = WT + (size_t)(c0 + r32) * K + 8 * hi; const bf16_t* b1 = WT + (size_t)(c1 + r32) * K + 8 * hi;
#pragma unroll 4
        for (int k0 = 0; k0 < K; k0 += 16) {
            const bf16x8 fa0 = *(const bf16x8*)(a0 + k0), fa1 = *(const bf16x8*)(a1 + k0), fb0 = *(const bf16x8*)(b0 + k0), fb1 = *(const bf16x8*)(b1 + k0);
            acc[0][0] = __builtin_amdgcn_mfma_f32_32x32x16_bf16(fa0, fb0, acc[0][0], 0, 0, 0);
            acc[0][1] = __builtin_amdgcn_mfma_f32_32x32x16_bf16(fa0, fb1, acc[0][1], 0, 0, 0);
            acc[1][0] = __builtin_amdgcn_mfma_f32_32x32x16_bf16(fa1, fb0, acc[1][0], 0, 0, 0);
            acc[1][1] = __builtin_amdgcn_mfma_f32_32x32x16_bf16(fa1, fb1, acc[1][1], 0, 0, 0);
        }
#pragma unroll
        for (int i = 0; i < 2; ++i)
#pragma unroll
            for (int r = 0; r < 16; ++r) {
                const size_t row = (size_t)(row0 + 32 * i + crow(r, hi));
                if (EPI == 0) { Yo[row * N + c0 + r32] = acc[i][0][r]; Yo[row * N + c1 + r32] = acc[i][1][r]; }
                else if (EPI == 1) { const float g = acc[i][0][r], u = acc[i][1][r]; const float h = g / (1.f + __expf(-g)) * u;
                    Po[row * FF + (cbk >> 2) * 128 + 32 * (cbk & 3) + r32] = (bf16_t)f2bf(h); }
                else { if (c0 < 3072) { Po[row * ldp + c0 + r32] = (bf16_t)f2bf(acc[i][0][r]); Po[row * ldp + c1 + r32] = (bf16_t)f2bf(acc[i][1][r]); }
                       else if (c0 == 3072 && r32 < 16) FL[row * 16 + r32] = acc[i][0][r]; }
            }
    }
}

constexpr int AT_K = 0, AT_V = 8192, AT_CUM = 16384, AT_WS = 24576, AT_OST = 26624, AT_SCAN = 59392;
__device__ __forceinline__ float max3f(float a, float b, float c) { return fmaxf(fmaxf(a, b), c); }
__device__ __forceinline__ float rowmax32(const f32x16& p0, const f32x16& p1) {
    float a = max3f(p0[0], p0[1], p1[0]), b = max3f(p0[2], p0[3], p1[1]); a = max3f(a, p1[2], p1[3]);
#pragma unroll
    for (int r = 4; r < 16; r += 4) { a = max3f(a, p0[r], p0[r + 1]); b = max3f(b, p0[r + 2], p0[r + 3]); a = max3f(a, p1[r], p1[r + 1]); b = max3f(b, p1[r + 2], p1[r + 3]); }
    const float m = fmaxf(a, b);
    return fmaxf(m, __shfl_xor(m, 32));
}
__device__ __forceinline__ unsigned cvtpk(float lo, float hi) { return pk2(lo, hi); }
__device__ __forceinline__ void pv_mma(f32x16* o, int vb, bf16x8 pa0, bf16x8 pa1, bf16x8 pa2, bf16x8 pa3) {
#pragma unroll
    for (int d0 = 0; d0 < 2; ++d0) { s16x4 lo[4], hi[4];
#pragma unroll
        for (int ks = 0; ks < 4; ++ks) {
            asm volatile("ds_read_b64_tr_b16 %0,%1 offset:%c2" : "=&v"(lo[ks]) : "v"(vb), "i"(d0 * 4096 + ks * 1024) : "memory");
            asm volatile("ds_read_b64_tr_b16 %0,%1 offset:%c2" : "=&v"(hi[ks]) : "v"(vb), "i"(d0 * 4096 + ks * 1024 + 512) : "memory"); }
        asm volatile("s_waitcnt lgkmcnt(0)" ::: "memory"); __builtin_amdgcn_sched_barrier(0);
#define PK(k) (bf16x8){lo[k][0], lo[k][1], lo[k][2], lo[k][3], hi[k][0], hi[k][1], hi[k][2], hi[k][3]}
        o[d0] = __builtin_amdgcn_mfma_f32_32x32x16_bf16(pa0, PK(0), o[d0], 0, 0, 0);
        o[d0] = __builtin_amdgcn_mfma_f32_32x32x16_bf16(pa1, PK(1), o[d0], 0, 0, 0);
        o[d0] = __builtin_amdgcn_mfma_f32_32x32x16_bf16(pa2, PK(2), o[d0], 0, 0, 0);
        o[d0] = __builtin_amdgcn_mfma_f32_32x32x16_bf16(pa3, PK(3), o[d0], 0, 0, 0);
#undef PK
    }
}

__device__ __forceinline__ void attn_phase(const Params& p, int jf, LAS unsigned char* lds, int tid, int lane, int wave) {
    const bf16_t* P = (const bf16_t*)(p.ws + WS_P);
    const float* FL = (const float*)(p.ws + WS_FL);
    bf16_t* U = (bf16_t*)(p.ws + WS_U);
    const int r32 = lane & 31, hi = lane >> 5;
    LAS float* cum = (LAS float*)(lds + AT_CUM);
    LAS float* wsf = (LAS float*)(lds + AT_WS) + wave * 64;
    LAS float* scanw = (LAS float*)(lds + AT_SCAN);
    const float C2 = 0.125f * L2E;
    for (int v = blockIdx.x; v < 256; v += gridDim.x) {
        const int bh = v >> 1, b = bh >> 4, h = bh & 15;
        const size_t rowbase = (size_t)b * SEQ;
        __syncthreads();
        { const float bf = p.in[9][jf * 16 + h]; float ls[4]; float run = 0.f;
#pragma unroll
          for (int i = 0; i < 4; ++i) { const float z = FL[(rowbase + 4 * tid + i) * 16 + h] + bf;
              const float lsg = (z >= 0.f) ? -log1pf(__expf(-z)) : (z - log1pf(__expf(z))); run += lsg; ls[i] = run; }
          float inc = run;
#pragma unroll
          for (int o = 1; o < 64; o <<= 1) { const float t = __shfl_up(inc, o); if (lane >= o) inc += t; }
          if (lane == 63) scanw[wave] = inc;
          __syncthreads();
          float off = inc - run;
          for (int w = 0; w < wave; ++w) off += scanw[w];
#pragma unroll
          for (int i = 0; i < 4; ++i) cum[4 * tid + i] = (off + ls[i]) * L2E;
        }
        __syncthreads();
        for (int ui = 0; ui < 4; ++ui) {
            const int qb = (v & 1) ? ((ui == 0) ? 1 : (ui == 1) ? 6 : (ui == 2) ? 3 : 4) : ((ui == 0) ? 0 : (ui == 1) ? 7 : (ui == 2) ? 2 : 5);
            const int q0 = qb * 256, qw0 = q0 + 32 * wave, myq = qw0 + r32;
            bf16x8 qr[4];
#pragma unroll
            for (int d0 = 0; d0 < 4; ++d0) qr[d0] = *(const bf16x8*)(P + (rowbase + myq) * 3072 + h * 64 + d0 * 16 + hi * 8);
            const float cq = cum[myq];
            float mrun = -1e30f, lrun = 0.f; f32x16 o[2];
#pragma unroll
            for (int r = 0; r < 16; ++r) { o[0][r] = 0.f; o[1][r] = 0.f; }
            const int NT = (q0 + 256) / 64;
            for (int t = 0; t < NT; ++t) {
                __syncthreads();
                { const u32x4 kv = *(const u32x4*)(P + (rowbase + 64 * t + lane) * 3072 + 1024 + h * 64 + 8 * wave);
                  *(LAS u32x4*)(lds + AT_K + wave * 1024 + lane * 16) = kv;
                  const int vr = 16 * (wave & 3) + (lane >> 2), vc = (wave >> 2) * 32 + (lane & 3) * 8;
                  const u32x4 vv = *(const u32x4*)(P + (rowbase + 64 * t + vr) * 3072 + 2048 + h * 64 + vc);
                  *(LAS u32x4*)(lds + AT_V + wave * 1024 + lane * 16) = vv; }
                __syncthreads();
                if (64 * t <= qw0 + 31) {
                    f32x16 s0, s1;
#pragma unroll
                    for (int r = 0; r < 16; ++r) { s0[r] = 0.f; s1[r] = 0.f; }
                    const LAS unsigned char* kb = lds + AT_K + hi * 1024 + r32 * 16;
#pragma unroll
                    for (int d0 = 0; d0 < 4; ++d0) {
                        const bf16x8 k0 = *(const LAS bf16x8*)(kb + d0 * 2048), k1 = *(const LAS bf16x8*)(kb + d0 * 2048 + 512);
                        s0 = __builtin_amdgcn_mfma_f32_32x32x16_bf16(k0, qr[d0], s0, 0, 0, 0);
                        s1 = __builtin_amdgcn_mfma_f32_32x32x16_bf16(k1, qr[d0], s1, 0, 0, 0); }
#pragma unroll
                    for (int g = 0; g < 4; ++g) { const f32x4 c0 = *(const LAS f32x4*)(cum + 64 * t + 8 * g + 4 * hi), c1 = *(const LAS f32x4*)(cum + 64 * t + 32 + 8 * g + 4 * hi);
#pragma unroll
                        for (int e = 0; e < 4; ++e) { s0[4 * g + e] = fmaf(s0[4 * g + e], C2, cq - c0[e]); s1[4 * g + e] = fmaf(s1[4 * g + e], C2, cq - c1[e]); } }
                    if (64 * t + 63 > qw0) {
#pragma unroll
                        for (int r = 0; r < 16; ++r) { const int kv = 64 * t + crow(r, hi); if (kv > myq) s0[r] = -INFINITY; if (kv + 32 > myq) s1[r] = -INFINITY; }
                    }
                    const float rm = rowmax32(s0, s1), mnew = fmaxf(mrun, rm), alpha = __builtin_amdgcn_exp2f(mrun - mnew);
                    mrun = mnew;
                    float sacc = 0.f;
#pragma unroll
                    for (int r = 0; r < 16; ++r) { s0[r] = __builtin_amdgcn_exp2f(s0[r] - mnew); s1[r] = __builtin_amdgcn_exp2f(s1[r] - mnew); sacc += s0[r] + s1[r]; }
                    lrun = lrun * alpha + sacc;
                    if (hi == 0) wsf[r32] = alpha;
                    LDS_WAIT();
#pragma unroll
                    for (int r = 0; r < 16; ++r) { const float f = wsf[crow(r, hi)]; o[0][r] *= f; o[1][r] *= f; }
                    u32x4 pw0, pw1, pw2, pw3;
                    pw0 = (u32x4){cvtpk(s0[0], s0[1]), cvtpk(s0[2], s0[3]), cvtpk(s0[4], s0[5]), cvtpk(s0[6], s0[7])};
                    pw1 = (u32x4){cvtpk(s0[8], s0[9]), cvtpk(s0[10], s0[11]), cvtpk(s0[12], s0[13]), cvtpk(s0[14], s0[15])};
                    pw2 = (u32x4){cvtpk(s1[0], s1[1]), cvtpk(s1[2], s1[3]), cvtpk(s1[4], s1[5]), cvtpk(s1[6], s1[7])};
                    pw3 = (u32x4){cvtpk(s1[8], s1[9]), cvtpk(s1[10], s1[11]), cvtpk(s1[12], s1[13]), cvtpk(s1[14], s1[15])};
                    const int vb = (int)(unsigned)(uintptr_t)(lds + AT_V) + ((lane >> 4) & 1) * 32 + (lane & 3) * 8 + (4 * hi + ((lane & 15) >> 2)) * 64;
                    pv_mma(o, vb, __builtin_bit_cast(bf16x8, pw0), __builtin_bit_cast(bf16x8, pw1), __builtin_bit_cast(bf16x8, pw2), __builtin_bit_cast(bf16x8, pw3));
                }
            }
            lrun += __shfl_xor(lrun, 32);
            LDS_WAIT();
            if (hi == 0) wsf[32 + r32] = lrun;
            LDS_WAIT();
            LAS bf16_t* stg = (LAS bf16_t*)(lds + AT_OST) + wave * 2048;
#pragma unroll
            for (int r = 0; r < 16; ++r) { const int orow = crow(r, hi); const float rl = 1.0f / wsf[32 + orow];
                stg[orow * 64 + r32] = (bf16_t)f2bf(o[0][r] * rl); stg[orow * 64 + 32 + r32] = (bf16_t)f2bf(o[1][r] * rl); }
            LDS_WAIT();
#pragma unroll
            for (int i = 0; i < 4; ++i) { const int row = i * 8 + (lane >> 3), ch = lane & 7; const u32x4 vv = *(const LAS u32x4*)(stg + row * 64 + ch * 8);
                *(u32x4*)(U + (rowbase + qw0 + row) * D + h * 64 + ch * 8) = vv; }
            LDS_WAIT();
        }
    }
}

__device__ __forceinline__ void sconv_phase(const Params& p, int tid) {
    const bf16_t* P = (const bf16_t*)(p.ws + WS_P);
    bf16_t* U = (bf16_t*)(p.ws + WS_U);
    const float* cw = p.in[12];
    for (int id = blockIdx.x * NTHR + tid; id < NB * 128 * 128; id += gridDim.x * NTHR) {
        const int c8 = id & 127, tch = (id >> 7) & 127, b = id >> 14, ch0 = c8 * 8, t0 = tch * 16;
        float w0[8], w1[8], w2[8], pm2[8], pm1[8];
#pragma unroll
        for (int e = 0; e < 8; ++e) { w0[e] = cw[ch0 + e]; w1[e] = cw[D + ch0 + e]; w2[e] = cw[2 * D + ch0 + e]; pm2[e] = 0.f; pm1[e] = 0.f; }
#pragma unroll
        for (int tt = -2; tt < 16; ++tt) {
            const int t = t0 + tt;
            float pr[8];
            if (t >= 0) { const bf16_t* row = P + ((size_t)b * SEQ + t) * 3072 + ch0;
                const u32x4 cg_ = *(const u32x4*)(row + 1024), xv = *(const u32x4*)(row + 2048);
#pragma unroll
                for (int e = 0; e < 4; ++e) { pr[2 * e] = bf2f(cg_[e] & 0xffffu) * bf2f(xv[e] & 0xffffu); pr[2 * e + 1] = bf2f(cg_[e] >> 16) * bf2f(xv[e] >> 16); }
            } else {
#pragma unroll
                for (int e = 0; e < 8; ++e) pr[e] = 0.f; }
            if (tt >= 0) { const bf16_t* row = P + ((size_t)b * SEQ + t) * 3072 + ch0; const u32x4 bg = *(const u32x4*)row; float ov[8];
#pragma unroll
                for (int e = 0; e < 4; ++e) { ov[2 * e] = bf2f(bg[e] & 0xffffu) * (w0[2 * e] * pm2[2 * e] + w1[2 * e] * pm1[2 * e] + w2[2 * e] * pr[2 * e]);
                    ov[2 * e + 1] = bf2f(bg[e] >> 16) * (w0[2 * e + 1] * pm2[2 * e + 1] + w1[2 * e + 1] * pm1[2 * e + 1] + w2[2 * e + 1] * pr[2 * e + 1]); }
                u32x4 o; o.x = pk2(ov[0], ov[1]); o.y = pk2(ov[2], ov[3]); o.z = pk2(ov[4], ov[5]); o.w = pk2(ov[6], ov[7]);
                *(u32x4*)(U + ((size_t)b * SEQ + t) * D + ch0) = o; }
#pragma unroll
            for (int e = 0; e < 8; ++e) { pm2[e] = pm1[e]; pm1[e] = pr[e]; }
        }
    }
}

constexpr int LR_XC = 0, LR_A = 36864, LR_B = 69632, LR_AGG = 102400, LR_CARRY = 106496, LR_CW = 106752;
__device__ __forceinline__ float gelu_tanh(float g) { const float u2 = 1.5957691216057308f * (g + 0.044715f * g * g * g); return g / (1.f + __expf(-u2)); }
__device__ __forceinline__ float neg_expm1(float x) {
    const float em = x * (1.f + x * (0.5f + x * (0.16666667f + x * (0.041666668f + x * 0.008333334f))));
    return (x < -0.25f) ? (1.f - __expf(x)) : -em; }
__device__ __forceinline__ float sigmoidf_(float z) { return 1.f / (1.f + __expf(-z)); }
__device__ __forceinline__ void lru_phase(const Params& p, LAS unsigned char* lds, int tid, int lane, int wave) {
    const bf16_t* P = (const bf16_t*)(p.ws + WS_P);
    bf16_t* U = (bf16_t*)(p.ws + WS_U);
    const int r32 = lane & 31, hi = lane >> 5;
    LAS float* LA = (LAS float*)(lds + LR_A); LAS float* LB = (LAS float*)(lds + LR_B);
    LAS float* AGG = (LAS float*)(lds + LR_AGG); LAS float* CARRY = (LAS float*)(lds + LR_CARRY); LAS float* CW = (LAS float*)(lds + LR_CW);
    for (int v = blockIdx.x; v < 256; v += gridDim.x) {
        const int b = v >> 5, n = (v >> 1) & 15, j = v & 1;
        const size_t rowbase = (size_t)b * SEQ;
        __syncthreads();
        if (tid < 256) CW[tid] = p.in[15][(tid >> 6) * D + 64 * n + (tid & 63)];
        else if (tid < 320) CW[tid] = p.in[16][64 * n + (tid - 256)];
        if (tid < 64) CARRY[tid] = 0.f;
        bf16x8 wfa[4], wfx[4];
        { const float* wa = p.in[17] + (size_t)n * 4096 + 32 * j + r32; const float* wx = p.in[19] + (size_t)n * 4096 + 32 * j + r32;
#pragma unroll
          for (int ks = 0; ks < 4; ++ks) { u32x4 ta, tx;
#pragma unroll
              for (int e = 0; e < 4; ++e) { const int k = 16 * ks + 8 * hi + 2 * e;
                  ta[e] = pk2(wa[(size_t)k * 64], wa[(size_t)(k + 1) * 64]); tx[e] = pk2(wx[(size_t)k * 64], wx[(size_t)(k + 1) * 64]); }
              wfa[ks] = __builtin_bit_cast(bf16x8, ta); wfx[ks] = __builtin_bit_cast(bf16x8, tx); } }
        const int chg = 64 * n + 32 * j + r32;
        const float ba = p.in[18][chg], bx = p.in[20][chg];
        float sp; { const float z = -p.in[21][chg]; sp = fmaxf(z, 0.f) + log1pf(__expf(-fabsf(z))); }
        __syncthreads();
        for (int sb = 0; sb < 8; ++sb) {
            const int t0 = sb * 256;
            { const int tl = tid >> 1, kh = tid & 1;
#pragma unroll 1
              for (int c8 = 0; c8 < 4; ++c8) { const int kc = 32 * kh + 8 * c8; float acc[8];
#pragma unroll
                  for (int e = 0; e < 8; ++e) acc[e] = CW[256 + kc + e];
#pragma unroll
                  for (int jj = 0; jj < 4; ++jj) { const int t = t0 + tl - 3 + jj;
                      if (t >= 0) { const u32x4 xv = *(const u32x4*)(P + (rowbase + t) * 2048 + 1024 + 64 * n + kc);
#pragma unroll
                          for (int e = 0; e < 4; ++e) { acc[2 * e] += CW[jj * 64 + kc + 2 * e] * bf2f(xv[e] & 0xffffu); acc[2 * e + 1] += CW[jj * 64 + kc + 2 * e + 1] * bf2f(xv[e] >> 16); } } }
                  u32x4 o; o.x = pk2(acc[0], acc[1]); o.y = pk2(acc[2], acc[3]); o.z = pk2(acc[4], acc[5]); o.w = pk2(acc[6], acc[7]);
                  *(LAS u32x4*)(lds + LR_XC + tl * 144 + kc * 2) = o; } }
            __syncthreads();
            { f32x16 ra, rx;
#pragma unroll
              for (int r = 0; r < 16; ++r) { ra[r] = 0.f; rx[r] = 0.f; }
#pragma unroll
              for (int ks = 0; ks < 4; ++ks) { const bf16x8 af = *(const LAS bf16x8*)(lds + LR_XC + (32 * wave + r32) * 144 + (16 * ks + 8 * hi) * 2);
                  ra = __builtin_amdgcn_mfma_f32_32x32x16_bf16(af, wfa[ks], ra, 0, 0, 0);
                  rx = __builtin_amdgcn_mfma_f32_32x32x16_bf16(af, wfx[ks], rx, 0, 0, 0); }
#pragma unroll
              for (int r = 0; r < 16; ++r) { const int tl = 32 * wave + crow(r, hi);
                  const float xc = bf2f(*(const LAS bf16_t*)(lds + LR_XC + tl * 144 + (32 * j + r32) * 2));
                  const float rg = sigmoidf_(ra[r] + ba), ig = sigmoidf_(rx[r] + bx);
                  const float la = -8.0f * rg * sp, a = __expf(la), mult = sqrtf(neg_expm1(2.0f * la));
                  LA[tl * 32 + r32] = a; LB[tl * 32 + r32] = mult * ig * xc; } }
            __syncthreads();
            { const int ch = tid & 31, tc = tid >> 5;
              float Aa = 1.f, Bv = 0.f;
#pragma unroll 4
              for (int i = 0; i < 16; ++i) { const float a = LA[(16 * tc + i) * 32 + ch], bb = LB[(16 * tc + i) * 32 + ch]; Bv = a * Bv + bb; Aa *= a; }
              AGG[tc * 64 + ch] = Aa; AGG[tc * 64 + 32 + ch] = Bv;
              __syncthreads();
              float hst = CARRY[(sb & 1) * 32 + ch];
              for (int c = 0; c < tc; ++c) hst = AGG[c * 64 + ch] * hst + AGG[c * 64 + 32 + ch];
#pragma unroll 4
              for (int i = 0; i < 16; ++i) { const int tl = 16 * tc + i; hst = LA[tl * 32 + ch] * hst + LB[tl * 32 + ch];
                  const float g = bf2f(P[(rowbase + t0 + tl) * 2048 + 64 * n + 32 * j + ch]);
                  U[(rowbase + t0 + tl) * D + 64 * n + 32 * j + ch] = (bf16_t)f2bf(hst * gelu_tanh(g)); }
              if (tc == 15) CARRY[((sb + 1) & 1) * 32 + ch] = hst; }
            __syncthreads();
        }
    }
}

__global__ void __launch_bounds__(NTHR, 2) fwd_megakernel(Params p) {
    extern __shared__ __attribute__((aligned(16))) unsigned char lds_raw[];
    LAS unsigned char* lds = (LAS unsigned char*)lds_raw;
    cg::grid_group grid = cg::this_grid();
    const int tid0 = threadIdx.x, wave = __builtin_amdgcn_readfirstlane(tid0 >> 6);
    unsigned char* ws = p.ws;
    bf16_t* XN = (bf16_t*)(ws + WS_XN); bf16_t* Ub = (bf16_t*)(ws + WS_U); bf16_t* Pb = (bf16_t*)(ws + WS_P);
    float* Y = (float*)(ws + WS_Y); float* FL = (float*)(ws + WS_FL);
    for (int ph = p.ph_lo; ph < p.ph_hi; ++ph) {
        int tid = tid0; asm volatile("" : "+v"(tid));
        const int lane = tid & 63;
        if (ph == 0) prologue_phase(p, lds, tid, lane, wave);
        else if (ph == NPH - 1) thin_phase(p, 3, 2, -1, 0, p.out, lane, wave);
        else {
            const int i = (ph - 1) / 10, k = (ph - 1) % 10, kind = i % 3, jm = i / 3;
            if (k == 0) { if (i == 0) thin_phase(p, -1, 0, 0, 0, p.in[0], lane, wave); else thin_phase(p, i - 1, 2, i, 0, p.out, lane, wave); }
            else if (k == 3) thin_phase(p, i, 0, i, 1, p.out, lane, wave);
            else if (k == 7) thin_phase(p, i, 1, i, 2, p.out, lane, wave);
            else if (k == 1 || k == 8) { const int s = (k == 1) ? 0 : 1;
                gemm_simple<1>(XN, (const bf16_t*)(ws + WS_WFI) + (size_t)(i * 2 + s) * 2 * FF * D, D, 2 * FF, nullptr, Pb, 0, nullptr, lane, wave); }
            else if (k == 2 || k == 9) { const int s = (k == 2) ? 0 : 1;
                gemm_simple<0>(Pb, (const bf16_t*)(ws + WS_WFO) + (size_t)(i * 2 + s) * D * FF, FF, D, Y, nullptr, 0, nullptr, lane, wave); }
            else if (k == 4) {
                if (kind == 0) gemm_simple<2>(XN, (const bf16_t*)(ws + WS_FOXI) + (size_t)jm * 3328 * D, D, 3328, nullptr, Pb, 3072, FL, lane, wave);
                else if (kind == 1) gemm_simple<2>(XN, (const bf16_t*)(ws + WS_SCI), D, 3072, nullptr, Pb, 3072, FL, lane, wave);
                else gemm_simple<2>(XN, (const bf16_t*)(ws + WS_LRI), D, 2048, nullptr, Pb, 2048, FL, lane, wave); }
            else if (k == 5) {
                if (kind == 0) attn_phase(p, jm, lds, tid, lane, wave);
                else if (kind == 1) sconv_phase(p, tid);
                else lru_phase(p, lds, tid, lane, wave); }
            else {
                const bf16_t* W = (kind == 0) ? (const bf16_t*)(ws + WS_FOXO) + (size_t)jm * D * D : (kind == 1) ? (const bf16_t*)(ws + WS_SCO) : (const bf16_t*)(ws + WS_LRO);
                gemm_simple<0>(Ub, W, D, D, Y, nullptr, 0, nullptr, lane, wave); }
        }
        if (ph + 1 < p.ph_hi) grid.sync();
    }
}

extern "C" void kernel_launch(void* const* d_in, const int* in_sizes, int n_in, void* d_out, int out_size, void* d_ws, size_t ws_size, hipStream_t stream) {
    static int grid = 0;
    if (grid == 0) {
        if (n_in != 23 || out_size != M * D || ws_size < WS_END) { fprintf(stderr, "kernel_launch: unexpected problem (n_in %d out %d ws %zu)\n", n_in, out_size, ws_size); grid = -1; return; }
        int dev = 0, cus = 0, per_cu = 0;
        hipGetDevice(&dev); hipDeviceGetAttribute(&cus, hipDeviceAttributeMultiprocessorCount, dev);
        hipFuncSetAttribute((const void*)fwd_megakernel, hipFuncAttributeMaxDynamicSharedMemorySize, LDS_BYTES);
        hipOccupancyMaxActiveBlocksPerMultiprocessor(&per_cu, (const void*)fwd_megakernel, NTHR, LDS_BYTES);
        if (per_cu < 1) per_cu = 1;
        (void)hipGetLastError();
        grid = cus;
        if (grid > 256) grid = 256;
    }
    if (grid < 0) return;
    Params p{};
    for (int i = 0; i < 23; ++i) p.in[i] = (const float*)d_in[i];
    p.out = (float*)d_out; p.ws = (unsigned char*)d_ws; p.ph_lo = 0; p.ph_hi = NPH;
    void* args[] = {&p};
    hipError_t e = hipLaunchCooperativeKernel((const void*)fwd_megakernel, dim3(grid), dim3(NTHR), args, LDS_BYTES, stream);
    if (e != hipSuccess) fprintf(stderr, "cooperative launch failed: %s (grid %d)\n", hipGetErrorString(e), grid);
}
```

```cpp
#include <hip/hip_runtime.h>
#include <hip/hip_cooperative_groups.h>
#include <cstdio>
#include <cstdint>
namespace cg = cooperative_groups;

#define LAS __attribute__((address_space(3)))
typedef unsigned short bf16_t;
typedef short bf16x8 __attribute__((ext_vector_type(8)));
typedef short s16x4 __attribute__((ext_vector_type(4)));
typedef float f32x4 __attribute__((ext_vector_type(4)));
typedef float f32x16 __attribute__((ext_vector_type(16)));
typedef unsigned u32x4 __attribute__((ext_vector_type(4)));
typedef unsigned u32x2 __attribute__((ext_vector_type(2)));

constexpr int D = 1024, NB = 8, SEQ = 2048, M = NB * SEQ, FF = 2816, NLAYER = 4, MODW = 9216;
constexpr int NWAVES = 8, NTHR = 512;
constexpr int LDS_BYTES = 147456;
constexpr int NPH = 42;
constexpr float RMS_EPS = 1e-6f;
constexpr float L2E = 1.4426950408889634f;

constexpr size_t MiB = 1u << 20;
constexpr size_t WS_MOD = 0;
constexpr size_t WS_FL = 2 * MiB;
constexpr size_t WS_WFI = 4 * MiB;
constexpr size_t WS_WFO = 92 * MiB;
constexpr size_t WS_FOXI = 136 * MiB;
constexpr size_t WS_FOXO = 149 * MiB;
constexpr size_t WS_SCI = 153 * MiB;
constexpr size_t WS_SCO = 159 * MiB;
constexpr size_t WS_LRI = 161 * MiB;
constexpr size_t WS_LRO = 165 * MiB;
constexpr size_t WS_XN = 168 * MiB;
constexpr size_t WS_U = 200 * MiB;
constexpr size_t WS_Y = 232 * MiB;
constexpr size_t WS_P = 296 * MiB;
constexpr size_t WS_END = 392 * MiB;

struct Params { const float* in[23]; float* out; unsigned char* ws; int ph_lo, ph_hi; };

__device__ __forceinline__ unsigned f2bf(float f) { unsigned u = __builtin_bit_cast(unsigned, f); return (u + 0x7fffu + ((u >> 16) & 1u)) >> 16; }
__device__ __forceinline__ unsigned pk2(float lo, float hi) { return f2bf(lo) | (f2bf(hi) << 16); }
__device__ __forceinline__ float bf2f(unsigned h) { return __uint_as_float(h << 16); }
__device__ __forceinline__ int crow(int r, int hi) { return (r & 3) + 8 * (r >> 2) + 4 * hi; }
__device__ __forceinline__ float wave_sum(float v) {
#pragma unroll
    for (int o = 1; o < 64; o <<= 1) v += __shfl_xor(v, o);
    return v;
}
#define LDS_WAIT() asm volatile("s_waitcnt lgkmcnt(0)" ::: "memory")

__device__ __forceinline__ void transpose_item(const float* W, int ld, int K, bf16_t* WT, int k0, int n0, int dst_row0, LAS float* scr, int lane) {
#pragma unroll 8
    for (int i = 0; i < 32; ++i) { const int kk = 2 * i + (lane >> 5); scr[kk * 33 + (lane & 31)] = W[(size_t)(k0 + kk) * ld + n0 + (lane & 31)]; }
    LDS_WAIT(); asm volatile("" ::: "memory");
    const int c = lane & 7;
#pragma unroll
    for (int j = 0; j < 4; ++j) { const int n = (lane >> 3) + 8 * j; const LAS float* s = scr + (8 * c) * 33 + n;
        u32x4 o; o.x = pk2(s[0 * 33], s[1 * 33]); o.y = pk2(s[2 * 33], s[3 * 33]); o.z = pk2(s[4 * 33], s[5 * 33]); o.w = pk2(s[6 * 33], s[7 * 33]);
        *(u32x4*)(WT + (size_t)(dst_row0 + n) * K + k0 + 8 * c) = o; }
    LDS_WAIT(); asm volatile("" ::: "memory");
}
__device__ __forceinline__ void transpose_matrix_item(const float* W, int ld, int K, int N, bf16_t* WT, int mode, int item, LAS float* scr, int lane) {
    const int nblk = N / 32, kb = item / nblk, nb = item % nblk, n0 = 32 * nb;
    int dr = n0;
    if (mode == 1) { if (n0 < FF) dr = (n0 >> 7) * 256 + (n0 & 127); else { const int j = n0 - FF; dr = (j >> 7) * 256 + 128 + (j & 127); } }
    transpose_item(W, ld, K, WT, 64 * kb, n0, dr, scr, lane);
}

__device__ __forceinline__ void prologue_phase(const Params& p, LAS unsigned char* lds, int tid, int lane, int wave) {
    unsigned char* ws = p.ws;
    LAS float* cact = (LAS float*)lds;
    LAS float* part = (LAS float*)(lds + 32768);
    for (int i = tid; i < NB * D; i += NTHR) { const float v = p.in[1][i]; cact[i] = v / (1.f + __expf(-v)); }
    __syncthreads();
    float* MOD = (float*)(ws + WS_MOD);
    for (int task = blockIdx.x; task < NLAYER * MODW / 64; task += gridDim.x) {
        const int gc = task * 64, li = gc / MODW, n0 = gc % MODW;
        const float* W = p.in[2] + (size_t)li * D * MODW + n0 + lane;
        float acc[NB];
#pragma unroll
        for (int b = 0; b < NB; ++b) acc[b] = 0.f;
        const int kbeg = wave * 128;
#pragma unroll 8
        for (int k = 0; k < 128; ++k) { const float w = W[(size_t)(kbeg + k) * MODW];
#pragma unroll
            for (int b = 0; b < NB; ++b) acc[b] += w * cact[b * D + kbeg + k]; }
#pragma unroll
        for (int b = 0; b < NB; ++b) part[(wave * NB + b) * 64 + lane] = acc[b];
        __syncthreads();
        { const int b = tid >> 6; float s = 0.f;
#pragma unroll
          for (int w = 0; w < NWAVES; ++w) s += part[(w * NB + b) * 64 + lane];
          MOD[(size_t)(li * NB + b) * MODW + n0 + lane] = s + p.in[3][li * MODW + n0 + lane]; }
        __syncthreads();
    }
    LAS float* scr = (LAS float*)(lds + 49152 + wave * 8448);
    const int gw = blockIdx.x * NWAVES + wave, NGW = gridDim.x * NWAVES;
    constexpr int I_FI = 16 * 176, I_FO = 44 * 32, I_FXI = 16 * 96, I_SQ = 16 * 32, I_LRI = 16 * 64;
    constexpr int E0 = 8 * I_FI, E1 = E0 + 8 * I_FO, E2 = E1 + 2 * I_FXI, E3 = E2 + 2 * I_SQ, E4 = E3 + I_FXI, E5 = E4 + I_SQ, E6 = E5 + I_LRI, E7 = E6 + I_SQ;
    for (int it = gw; it < E7; it += NGW) {
        if (it < E0) { const int m = it / I_FI, r = it % I_FI; transpose_matrix_item(p.in[6] + (size_t)m * D * 2 * FF, 2 * FF, D, 2 * FF, (bf16_t*)(ws + WS_WFI) + (size_t)m * 2 * FF * D, 1, r, scr, lane); }
        else if (it < E1) { const int q = it - E0, m = q / I_FO, r = q % I_FO; transpose_matrix_item(p.in[7] + (size_t)m * FF * D, D, FF, D, (bf16_t*)(ws + WS_WFO) + (size_t)m * D * FF, 0, r, scr, lane); }
        else if (it < E2) { const int q = it - E1, m = q / I_FXI, r = q % I_FXI; transpose_matrix_item(p.in[8] + (size_t)m * D * 3088, 3088, D, 3072, (bf16_t*)(ws + WS_FOXI) + (size_t)m * 3328 * D, 0, r, scr, lane); }
        else if (it < E3) { const int q = it - E2, m = q / I_SQ, r = q % I_SQ; transpose_matrix_item(p.in[10] + (size_t)m * D * D, D, D, D, (bf16_t*)(ws + WS_FOXO) + (size_t)m * D * D, 0, r, scr, lane); }
        else if (it < E4) { transpose_matrix_item(p.in[11], 3072, D, 3072, (bf16_t*)(ws + WS_SCI), 0, it - E3, scr, lane); }
        else if (it < E5) { transpose_matrix_item(p.in[13], D, D, D, (bf16_t*)(ws + WS_SCO), 0, it - E4, scr, lane); }
        else if (it < E6) { transpose_matrix_item(p.in[14], 2048, D, 2048, (bf16_t*)(ws + WS_LRI), 0, it - E5, scr, lane); }
        else { transpose_matrix_item(p.in[22], D, D, D, (bf16_t*)(ws + WS_LRO), 0, it - E6, scr, lane); }
    }
    const int gt = blockIdx.x * NTHR + tid, NGT = gridDim.x * NTHR;
    for (int e = gt; e < 2 * 256 * 128; e += NGT) {
        const int m = e / (256 * 128), r = (e / 128) % 256, kc = e % 128;
        u32x4 o = (u32x4){0u, 0u, 0u, 0u};
        if (r < 16) { const float* W = p.in[8] + (size_t)m * D * 3088 + 3072 + r; const int k = kc * 8;
            o.x = pk2(W[(size_t)(k + 0) * 3088], W[(size_t)(k + 1) * 3088]); o.y = pk2(W[(size_t)(k + 2) * 3088], W[(size_t)(k + 3) * 3088]);
            o.z = pk2(W[(size_t)(k + 4) * 3088], W[(size_t)(k + 5) * 3088]); o.w = pk2(W[(size_t)(k + 6) * 3088], W[(size_t)(k + 7) * 3088]); }
        *(u32x4*)((bf16_t*)(ws + WS_FOXI) + (size_t)m * 3328 * D + (size_t)(3072 + r) * D + kc * 8) = o;
    }
}

__device__ __forceinline__ void thin_phase(const Params& p, int ip, int sp, int in_, int sn, const float* xin, int lane, int wave) {
    const float* MOD = (const float*)(p.ws + WS_MOD);
    const float* Y = (const float*)(p.ws + WS_Y);
    bf16_t* XN = (bf16_t*)(p.ws + WS_XN);
    const int gw = blockIdx.x * NWAVES + wave, NGW = gridDim.x * NWAVES;
    for (int m = gw; m < M; m += NGW) {
        const int b = m >> 11;
        f32x4 x[4];
#pragma unroll
        for (int j = 0; j < 4; ++j) x[j] = *(const f32x4*)(xin + (size_t)m * D + 4 * lane + 256 * j);
        if (ip >= 0) {
            f32x4 y[4]; float ss = 0.f;
#pragma unroll
            for (int j = 0; j < 4; ++j) { y[j] = *(const f32x4*)(Y + (size_t)m * D + 4 * lane + 256 * j); ss += (y[j].x * y[j].x + y[j].y * y[j].y) + (y[j].z * y[j].z + y[j].w * y[j].w); }
            const float rstd = rsqrtf(wave_sum(ss) * (1.f / D) + RMS_EPS) * (sp == 1 ? 1.0f : 0.5f);
            const float* gate = MOD + (size_t)(ip * NB + b) * MODW + sp * 3072 + 2048;
            const float* npost = p.in[5] + (ip * 3 + sp) * D;
#pragma unroll
            for (int j = 0; j < 4; ++j) { const f32x4 g = *(const f32x4*)(gate + 4 * lane + 256 * j), n = *(const f32x4*)(npost + 4 * lane + 256 * j); x[j] = x[j] + g * (y[j] * rstd) * n; }
        }
        if (ip >= 0 || xin != p.out) {
#pragma unroll
            for (int j = 0; j < 4; ++j) *(f32x4*)(p.out + (size_t)m * D + 4 * lane + 256 * j) = x[j];
        }
        if (in_ >= 0) {
            float ss = 0.f;
#pragma unroll
            for (int j = 0; j < 4; ++j) ss += (x[j].x * x[j].x + x[j].y * x[j].y) + (x[j].z * x[j].z + x[j].w * x[j].w);
            const float rstd = rsqrtf(wave_sum(ss) * (1.f / D) + RMS_EPS);
            const float* shift = MOD + (size_t)(in_ * NB + b) * MODW + sn * 3072;
            const float* scale = shift + 1024;
            const float* npre = p.in[4] + (in_ * 3 + sn) * D;
#pragma unroll
            for (int j = 0; j < 4; ++j) { const f32x4 sh = *(const f32x4*)(shift + 4 * lane + 256 * j), sc = *(const f32x4*)(scale + 4 * lane + 256 * j), n = *(const f32x4*)(npre + 4 * lane + 256 * j);
                const f32x4 v = (x[j] * rstd) * n * (sc + 1.0f) + sh;
                u32x2 o; o.x = pk2(v.x, v.y); o.y = pk2(v.z, v.w);
                *(u32x2*)(XN + (size_t)m * D + 4 * lane + 256 * j) = o; }
        }
    }
}

namespace pg8 {
#define PG8_LAS __attribute__((address_space(3)))
typedef unsigned short bf16_t;
typedef short bf16x8 __attribute__((ext_vector_type(8)));
typedef float f32x4 __attribute__((ext_vector_type(4)));
typedef unsigned u32x4 __attribute__((ext_vector_type(4)));
constexpr int BM = 256, BK = 64, HALF = 128, HTB = HALF * BK * 2  , STAGE_BYTES = 8 * HTB, NXCD = 8, WGM = 8;

__host__ __device__ __forceinline__ int lds_byte(int r, int c) { const int st = (r >> 4) * 2 + (c >> 5), rr = r & 15, cc = c & 31, ob = rr * 64 + cc * 2; return st * 1024 + (ob ^ (((ob >> 9) & 1) << 5)); }
__host__ __device__ __forceinline__ void stage_rc(int b, int& R, int& C) { const int st = b / 1024, sb = b % 1024, swz = sb ^ (((sb >> 9) & 1) << 5); R = (st >> 1) * 16 + swz / 64; C = (st & 1) * 32 + (swz % 64) / 2; }
__host__ __device__ __forceinline__ int perm32(int rho) { const int n = rho >> 4, i = rho & 15; return 8 * (i >> 2) + 4 * n + (i & 3); }

struct Unit { int pm, pn; };
struct Gemm { const bf16_t* A; const bf16_t* Bt; int M, N, K; };

struct StaticOrder {
    int nM, nN, nwg, G, c;
    __host__ __device__ void init(int M, int N, int G_, int c_) { nM = M / BM; nN = N / BM; nwg = nM * nN; G = G_; c = c_; }
    __host__ __device__ bool next(int i, Unit& u) const {
        const long L = (long)i * G + c; if (L >= nwg) return false;
        int wgid = (int)L; { const int q = nwg / NXCD, r = nwg % NXCD, xcd = wgid % NXCD, off = wgid / NXCD; wgid = (xcd < r ? xcd * (q + 1) : r * (q + 1) + (xcd - r) * q) + off; }
        const int nig = WGM * nN, gid = wgid / nig, fm = gid * WGM, gsz = (nM - fm) < WGM ? (nM - fm) : WGM;
        u.pm = fm + ((wgid % nig) % gsz); u.pn = (wgid % nig) / gsz; return true;
    }
    __device__ __forceinline__ void a_ready(const Unit&) const {}
    __device__ __forceinline__ void done(const Unit&) const {}
};

__device__ __forceinline__ unsigned cvt_pk_bf16(float lo, float hi) { unsigned r; asm volatile("v_cvt_pk_bf16_f32 %0, %1, %2" : "=v"(r) : "v"(lo), "v"(hi)); return r; }
typedef float f32x2 __attribute__((ext_vector_type(2)));

struct EpiSwiglu {
    static constexpr bool PERM = true, AFTER_DRAIN = false;
    bf16_t* H; int ldh;
    __device__ __forceinline__ void operator()(const f32x4 (&acc)[2][2][4][2], const Unit& u, int wr, int wc, int fr, int fq) const {
        const int row0 = u.pm * BM + wr * 64 + fr, col0 = u.pn * 128 + wc * 32 + 8 * fq;
#pragma unroll
        for (int ai = 0; ai < 2; ++ai)
#pragma unroll
            for (int m = 0; m < 4; ++m) { bf16_t* rowp = H + (size_t)(row0 + ai * HALF + m * 16) * ldh + col0; float h[8];
#pragma unroll
                for (int n = 0; n < 2; ++n)
#pragma unroll
                    for (int e = 0; e < 4; ++e) { const float g = acc[ai][0][m][n][e], uu = acc[ai][1][m][n][e]; h[4 * n + e] = g * uu * __builtin_amdgcn_rcpf(1.f + __expf(-g)); }
                u32x4 w; w.x = cvt_pk_bf16(h[0], h[1]); w.y = cvt_pk_bf16(h[2], h[3]); w.z = cvt_pk_bf16(h[4], h[5]); w.w = cvt_pk_bf16(h[6], h[7]);
                *(u32x4*)rowp = w; }
    }
};
struct EpiF32 {
    static constexpr bool PERM = true, AFTER_DRAIN = false;
    float* Y; int ldc;
    __device__ __forceinline__ void operator()(const f32x4 (&acc)[2][2][4][2], const Unit& u, int wr, int wc, int fr, int fq) const {
        const int row0 = u.pm * BM + wr * 64 + fr, col0 = u.pn * BM + wc * 32 + 8 * fq;
#pragma unroll
        for (int ai = 0; ai < 2; ++ai)
#pragma unroll
            for (int m = 0; m < 4; ++m) { float* rowp = Y + (size_t)(row0 + ai * HALF + m * 16) * ldc + col0;
#pragma unroll
                for (int bj = 0; bj < 2; ++bj) { *(f32x4*)(rowp + bj * HALF) = acc[ai][bj][m][0]; *(f32x4*)(rowp + bj * HALF + 4) = acc[ai][bj][m][1]; } }
    }
};
struct EpiProj {
    static constexpr bool PERM = true, AFTER_DRAIN = false;
    bf16_t* P; int ldp; int ncol_main; float* FL;
    __device__ __forceinline__ void operator()(const f32x4 (&acc)[2][2][4][2], const Unit& u, int wr, int wc, int fr, int fq) const {
        const int row0 = u.pm * BM + wr * 64 + fr, colt = u.pn * BM;
        if (colt < ncol_main) {
            const int col0 = colt + wc * 32 + 8 * fq;
#pragma unroll
            for (int ai = 0; ai < 2; ++ai)
#pragma unroll
                for (int m = 0; m < 4; ++m) { bf16_t* rowp = P + (size_t)(row0 + ai * HALF + m * 16) * ldp + col0;
#pragma unroll
                    for (int bj = 0; bj < 2; ++bj) { const f32x4 v0 = acc[ai][bj][m][0], v1 = acc[ai][bj][m][1];
                        u32x4 w; w.x = cvt_pk_bf16(v0[0], v0[1]); w.y = cvt_pk_bf16(v0[2], v0[3]); w.z = cvt_pk_bf16(v1[0], v1[1]); w.w = cvt_pk_bf16(v1[2], v1[3]);
                        *(u32x4*)(rowp + bj * HALF) = w; } }
        } else if (wc == 0 && fq < 2) {
#pragma unroll
            for (int ai = 0; ai < 2; ++ai)
#pragma unroll
                for (int m = 0; m < 4; ++m) { float* rowp = FL + (size_t)(row0 + ai * HALF + m * 16) * 16 + 8 * fq;
                    *(f32x4*)rowp = acc[ai][0][m][0]; *(f32x4*)(rowp + 4) = acc[ai][0][m][1]; }
        }
    }
};
template <class Epi, class Sched, bool ALIGN_EPI = false, bool SP2 = false>
__device__ __forceinline__ void gemm_phase(PG8_LAS unsigned char* lds, const Gemm g, const Sched& S, const Epi& E) {
    int tid_ = threadIdx.x; asm volatile("" : "+v"(tid_));
    const int tid = tid_, wid = __builtin_amdgcn_readfirstlane(tid >> 6), lane = tid & 63, wr = wid >> 2, wc = wid & 3, fr = lane & 15, fq = lane >> 4;
    const int K = g.K, nt = K / BK;
    unsigned voffA[2], voffB[2];
#pragma unroll
    for (int i = 0; i < 2; ++i) { int R, C; stage_rc(tid * 16 + i * 8192, R, C); const int Rb = Epi::PERM ? ((R & ~31) + perm32(R & 31)) : R;
        voffA[i] = (unsigned)(R * K + C) * 2u; voffB[i] = (unsigned)(Rb * K + C) * 2u; }
    const size_t kstep = (size_t)(BK * 2);
    const size_t hstep = (size_t)HALF * K * 2;
    const size_t tstep = 2 * hstep;
    const unsigned ldsw = (unsigned)wid * 1024u;
    const int aoff = lds_byte(wr * 64 + fr, fq * 8), boff = lds_byte(wc * 32 + fr, fq * 8);
#define PG8_SA(b, h) (((b) * 2 + (h)) * HTB)
#define PG8_SB(b, h) ((4 + (b) * 2 + (h)) * HTB)
#define PG8_STAGE(bufoff, gbase, voff) do { _Pragma("unroll") for (int _i = 0; _i < 2; ++_i) \
        __builtin_amdgcn_global_load_lds((const unsigned*)((const char*)(gbase) + (voff)[_i]), (PG8_LAS unsigned*)(lds + (bufoff) + ldsw + _i * 8192), 16, 0, 0); } while (0)
#define PG8_LDA(dst, b, h) do { _Pragma("unroll") for (int m = 0; m < 4; ++m) _Pragma("unroll") for (int k = 0; k < 2; ++k) dst[m][k] = *(const PG8_LAS bf16x8*)(lds + PG8_SA(b, h) + aoff + m * 2048 + k * 1024); } while (0)
#define PG8_LDB(dst, b, h) do { _Pragma("unroll") for (int n = 0; n < 2; ++n) _Pragma("unroll") for (int k = 0; k < 2; ++k) dst[n][k] = *(const PG8_LAS bf16x8*)(lds + PG8_SB(b, h) + boff + n * 2048 + k * 1024); } while (0)
#define PG8_MMA(ai, bj, At, Bt) do { __builtin_amdgcn_s_setprio(1); _Pragma("unroll") for (int m = 0; m < 4; ++m) _Pragma("unroll") for (int n = 0; n < 2; ++n) _Pragma("unroll") for (int k = 0; k < 2; ++k) \
        acc[ai][bj][m][n] = __builtin_amdgcn_mfma_f32_16x16x32_bf16(Bt[n][k], At[m][k], acc[ai][bj][m][n], 0, 0, 0); __builtin_amdgcn_s_setprio(0); } while (0)
#define PG8_WAIT_V(n) asm volatile("s_waitcnt vmcnt(" #n ")" ::: "memory")
#define PG8_WAIT_L(n) asm volatile("s_waitcnt lgkmcnt(" #n ")" ::: "memory")
#define PG8_BAR __builtin_amdgcn_s_barrier()
#define PG8_SCHED __builtin_amdgcn_sched_barrier(0)
    Unit cur, nxt; int ui = 0;
    if (!S.next(0, cur)) return;
    f32x4 acc[2][2][4][2];
#pragma unroll
    for (int a = 0; a < 2; ++a)
#pragma unroll
        for (int b = 0; b < 2; ++b)
#pragma unroll
            for (int m = 0; m < 4; ++m)
#pragma unroll
                for (int n = 0; n < 2; ++n) acc[a][b][m][n] = (f32x4){0.f, 0.f, 0.f, 0.f};
    bf16x8 At[4][2], B0[2][2], B1[2][2];
    const char* cA = (const char*)g.A + (size_t)cur.pm * tstep; const char* cB = (const char*)g.Bt + (size_t)cur.pn * tstep;
    S.a_ready(cur);
    if constexpr (SP2) {
        PG8_STAGE(PG8_SB(0, 0), cB, voffB); PG8_STAGE(PG8_SB(0, 1), cB + hstep, voffB); PG8_STAGE(PG8_SA(0, 0), cA, voffA); PG8_STAGE(PG8_SA(0, 1), cA + hstep, voffA);
        if (wr == 1) PG8_BAR;
        PG8_WAIT_V(2); PG8_BAR;
        PG8_STAGE(PG8_SB(1, 0), cB + kstep, voffB); PG8_STAGE(PG8_SA(1, 0), cA + kstep, voffA); PG8_STAGE(PG8_SB(1, 1), cB + hstep + kstep, voffB);
        PG8_WAIT_V(6); PG8_BAR;
    } else {
        PG8_STAGE(PG8_SB(0, 0), cB, voffB); PG8_STAGE(PG8_SA(0, 0), cA, voffA); PG8_STAGE(PG8_SB(0, 1), cB + hstep, voffB); PG8_STAGE(PG8_SA(0, 1), cA + hstep, voffA);
        if (wr == 1) PG8_BAR;
        PG8_WAIT_V(4); PG8_BAR;
        PG8_STAGE(PG8_SB(1, 0), cB + kstep, voffB); PG8_STAGE(PG8_SA(1, 0), cA + kstep, voffA); PG8_STAGE(PG8_SB(1, 1), cB + hstep + kstep, voffB);
        PG8_WAIT_V(6); PG8_BAR;
    }
    for (;;) {
        const bool has_next = S.next(ui + 1, nxt);
        const char* nA = has_next ? (const char*)g.A + (size_t)nxt.pm * tstep : cA; const char* nB = has_next ? (const char*)g.Bt + (size_t)nxt.pn * tstep : cB;
        for (int t = 0; t < nt; t += 2) {
            const bool last = (t == nt - 2);
            const char* a1 = cA + (size_t)(t + 1) * kstep;
            const char* a2 = last ? nA : cA + (size_t)(t + 2) * kstep; const char* b2 = last ? nB : cB + (size_t)(t + 2) * kstep;
            const char* a3 = a2 + kstep; const char* b3 = b2 + kstep;
            if (last && has_next) S.a_ready(nxt);
            if constexpr (SP2) {
            PG8_LDB(B0, 0, 0); PG8_LDB(B1, 0, 1); PG8_SCHED; PG8_LDA(At, 0, 0); PG8_STAGE(PG8_SA(1, 1), a1 + hstep, voffA);
            PG8_WAIT_V(8); PG8_WAIT_L(0); PG8_BAR; PG8_MMA(0, 0, At, B0); PG8_MMA(0, 1, At, B1); PG8_BAR; PG8_SCHED;
            PG8_LDA(At, 0, 1); PG8_STAGE(PG8_SB(0, 0), b2, voffB); PG8_STAGE(PG8_SB(0, 1), b2 + hstep, voffB); PG8_STAGE(PG8_SA(0, 0), a2, voffA);
            PG8_WAIT_V(8); PG8_WAIT_L(0); PG8_BAR; PG8_MMA(1, 0, At, B0); PG8_MMA(1, 1, At, B1); PG8_BAR; PG8_SCHED;
            PG8_LDB(B0, 1, 0); PG8_LDB(B1, 1, 1); PG8_SCHED; PG8_LDA(At, 1, 0); PG8_STAGE(PG8_SA(0, 1), a2 + hstep, voffA);
            PG8_WAIT_V(8); PG8_WAIT_L(0); PG8_BAR; PG8_MMA(0, 0, At, B0); PG8_MMA(0, 1, At, B1); PG8_BAR; PG8_SCHED;
            PG8_LDA(At, 1, 1); PG8_STAGE(PG8_SB(1, 0), b3, voffB); PG8_STAGE(PG8_SB(1, 1), b3 + hstep, voffB); PG8_STAGE(PG8_SA(1, 0), a3, voffA);
            PG8_WAIT_V(8); PG8_WAIT_L(0); PG8_BAR; PG8_MMA(1, 0, At, B0); PG8_MMA(1, 1, At, B1); PG8_BAR; PG8_SCHED;
            } else {
            PG8_LDB(B0, 0, 0); PG8_SCHED; PG8_LDA(At, 0, 0); PG8_STAGE(PG8_SA(1, 1), a1 + hstep, voffA);
            PG8_WAIT_L(8); PG8_BAR; PG8_WAIT_L(0); PG8_MMA(0, 0, At, B0); PG8_BAR; PG8_SCHED;
            PG8_LDB(B1, 0, 1); PG8_STAGE(PG8_SB(0, 0), b2, voffB);
            PG8_BAR; PG8_WAIT_L(0); PG8_MMA(0, 1, At, B1); PG8_BAR;
            PG8_LDA(At, 0, 1); PG8_STAGE(PG8_SA(0, 0), a2, voffA);
            PG8_BAR; PG8_WAIT_L(0); PG8_MMA(1, 0, At, B0); PG8_BAR; PG8_SCHED;
            PG8_STAGE(PG8_SB(0, 1), b2 + hstep, voffB);
            PG8_WAIT_V(6); PG8_BAR; PG8_MMA(1, 1, At, B1); PG8_BAR;
            PG8_LDB(B0, 1, 0); PG8_SCHED; PG8_LDA(At, 1, 0); PG8_STAGE(PG8_SA(0, 1), a2 + hstep, voffA);
            PG8_WAIT_L(8); PG8_BAR; PG8_WAIT_L(0); PG8_MMA(0, 0, At, B0); PG8_BAR; PG8_SCHED;
            PG8_LDB(B1, 1, 1); PG8_STAGE(PG8_SB(1, 0), b3, voffB);
            PG8_BAR; PG8_WAIT_L(0); PG8_MMA(0, 1, At, B1); PG8_BAR;
            PG8_LDA(At, 1, 1); PG8_STAGE(PG8_SA(1, 0), a3, voffA);
            PG8_BAR; PG8_WAIT_L(0); PG8_MMA(1, 0, At, B0); PG8_BAR; PG8_SCHED;
            PG8_STAGE(PG8_SB(1, 1), b3 + hstep, voffB);
            PG8_WAIT_V(6); PG8_BAR; PG8_MMA(1, 1, At, B1); PG8_BAR;
            }
        }
        if constexpr (ALIGN_EPI) { if (wr == 0) PG8_BAR; }
        if constexpr (!Epi::AFTER_DRAIN) { E(acc, cur, wr, wc, fr, fq); S.done(cur); }
        if (!has_next) break;
#pragma unroll
        for (int a = 0; a < 2; ++a)
#pragma unroll
            for (int b = 0; b < 2; ++b)
#pragma unroll
                for (int m = 0; m < 4; ++m)
#pragma unroll
                    for (int n = 0; n < 2; ++n) acc[a][b][m][n] = (f32x4){0.f, 0.f, 0.f, 0.f};
        cur = nxt; cA = nA; cB = nB; ++ui;
        if constexpr (ALIGN_EPI) { if (wr == 1) PG8_BAR; }
    }
    PG8_WAIT_V(0);
    if constexpr (!ALIGN_EPI) { if (wr == 0) PG8_BAR; }
    PG8_BAR;
    if constexpr (Epi::AFTER_DRAIN) { E.fused(acc, cur, wr, wc, fr, fq, lds, wid, lane); S.done(cur); }
#undef PG8_SA
#undef PG8_SB
#undef PG8_STAGE
#undef PG8_LDA
#undef PG8_LDB
#undef PG8_MMA
#undef PG8_WAIT_V
#undef PG8_WAIT_L
#undef PG8_BAR
#undef PG8_SCHED
}
}

constexpr int AT_K = 0, AT_V = 8192, AT_CUM = 16384, AT_WS = 24576, AT_OST = 26624, AT_SCAN = 59392;
__device__ __forceinline__ float max3f(float a, float b, float c) { return fmaxf(fmaxf(a, b), c); }
__device__ __forceinline__ float rowmax32(const f32x16& p0, const f32x16& p1) {
    float a = max3f(p0[0], p0[1], p1[0]), b = max3f(p0[2], p0[3], p1[1]); a = max3f(a, p1[2], p1[3]);
#pragma unroll
    for (int r = 4; r < 16; r += 4) { a = max3f(a, p0[r], p0[r + 1]); b = max3f(b, p0[r + 2], p0[r + 3]); a = max3f(a, p1[r], p1[r + 1]); b = max3f(b, p1[r + 2], p1[r + 3]); }
    const float m = fmaxf(a, b);
    return fmaxf(m, __shfl_xor(m, 32));
}
__device__ __forceinline__ unsigned cvtpk(float lo, float hi) { return pk2(lo, hi); }
__device__ __forceinline__ void pv_mma(f32x16* o, int vb, bf16x8 pa0, bf16x8 pa1, bf16x8 pa2, bf16x8 pa3) {
#pragma unroll
    for (int d0 = 0; d0 < 2; ++d0) { s16x4 lo[4], hi[4];
#pragma unroll
        for (int ks = 0; ks < 4; ++ks) {
            asm volatile("ds_read_b64_tr_b16 %0,%1 offset:%c2" : "=&v"(lo[ks]) : "v"(vb), "i"(d0 * 4096 + ks * 1024) : "memory");
            asm volatile("ds_read_b64_tr_b16 %0,%1 offset:%c2" : "=&v"(hi[ks]) : "v"(vb), "i"(d0 * 4096 + ks * 1024 + 512) : "memory"); }
        asm volatile("s_waitcnt lgkmcnt(0)" ::: "memory"); __builtin_amdgcn_sched_barrier(0);
#define PK(k) (bf16x8){lo[k][0], lo[k][1], lo[k][2], lo[k][3], hi[k][0], hi[k][1], hi[k][2], hi[k][3]}
        o[d0] = __builtin_amdgcn_mfma_f32_32x32x16_bf16(pa0, PK(0), o[d0], 0, 0, 0);
        o[d0] = __builtin_amdgcn_mfma_f32_32x32x16_bf16(pa1, PK(1), o[d0], 0, 0, 0);
        o[d0] = __builtin_amdgcn_mfma_f32_32x32x16_bf16(pa2, PK(2), o[d0], 0, 0, 0);
        o[d0] = __builtin_amdgcn_mfma_f32_32x32x16_bf16(pa3, PK(3), o[d0], 0, 0, 0);
#undef PK
    }
}

__device__ __forceinline__ void attn_phase(const Params& p, int jf, LAS unsigned char* lds, int tid, int lane, int wave) {
    const bf16_t* P = (const bf16_t*)(p.ws + WS_P);
    const float* FL = (const float*)(p.ws + WS_FL);
    bf16_t* U = (bf16_t*)(p.ws + WS_U);
    const int r32 = lane & 31, hi = lane >> 5;
    LAS float* cum = (LAS float*)(lds + AT_CUM);
    LAS float* wsf = (LAS float*)(lds + AT_WS) + wave * 64;
    LAS float* scanw = (LAS float*)(lds + AT_SCAN);
    const float C2 = 0.125f * L2E;
    for (int v = blockIdx.x; v < 256; v += gridDim.x) {
        const int bh = v >> 1, b = bh >> 4, h = bh & 15;
        const size_t rowbase = (size_t)b * SEQ;
        __syncthreads();
        { const float bf = p.in[9][jf * 16 + h]; float ls[4]; float run = 0.f;
#pragma unroll
          for (int i = 0; i < 4; ++i) { const float z = FL[(rowbase + 4 * tid + i) * 16 + h] + bf;
              const float lsg = (z >= 0.f) ? -log1pf(__expf(-z)) : (z - log1pf(__expf(z))); run += lsg; ls[i] = run; }
          float inc = run;
#pragma unroll
          for (int o = 1; o < 64; o <<= 1) { const float t = __shfl_up(inc, o); if (lane >= o) inc += t; }
          if (lane == 63) scanw[wave] = inc;
          __syncthreads();
          float off = inc - run;
          for (int w = 0; w < wave; ++w) off += scanw[w];
#pragma unroll
          for (int i = 0; i < 4; ++i) cum[4 * tid + i] = (off + ls[i]) * L2E;
        }
        __syncthreads();
        for (int ui = 0; ui < 4; ++ui) {
            const int qb = (v & 1) ? ((ui == 0) ? 1 : (ui == 1) ? 6 : (ui == 2) ? 3 : 4) : ((ui == 0) ? 0 : (ui == 1) ? 7 : (ui == 2) ? 2 : 5);
            const int q0 = qb * 256, qw0 = q0 + 32 * wave, myq = qw0 + r32;
            bf16x8 qr[4];
#pragma unroll
            for (int d0 = 0; d0 < 4; ++d0) qr[d0] = *(const bf16x8*)(P + (rowbase + myq) * 3072 + h * 64 + d0 * 16 + hi * 8);
            const float cq = cum[myq];
            float mrun = -1e30f, lrun = 0.f; f32x16 o[2];
#pragma unroll
            for (int r = 0; r < 16; ++r) { o[0][r] = 0.f; o[1][r] = 0.f; }
            const int NT = (q0 + 256) / 64;
            for (int t = 0; t < NT; ++t) {
                __syncthreads();
                { const u32x4 kv = *(const u32x4*)(P + (rowbase + 64 * t + lane) * 3072 + 1024 + h * 64 + 8 * wave);
                  *(LAS u32x4*)(lds + AT_K + wave * 1024 + lane * 16) = kv;
                  const int vr = 16 * (wave & 3) + (lane >> 2), vc = (wave >> 2) * 32 + (lane & 3) * 8;
                  const u32x4 vv = *(const u32x4*)(P + (rowbase + 64 * t + vr) * 3072 + 2048 + h * 64 + vc);
                  *(LAS u32x4*)(lds + AT_V + wave * 1024 + lane * 16) = vv; }
                __syncthreads();
                if (64 * t <= qw0 + 31) {
                    f32x16 s0, s1;
#pragma unroll
                    for (int r = 0; r < 16; ++r) { s0[r] = 0.f; s1[r] = 0.f; }
                    const LAS unsigned char* kb = lds + AT_K + hi * 1024 + r32 * 16;
#pragma unroll
                    for (int d0 = 0; d0 < 4; ++d0) {
                        const bf16x8 k0 = *(const LAS bf16x8*)(kb + d0 * 2048), k1 = *(const LAS bf16x8*)(kb + d0 * 2048 + 512);
                        s0 = __builtin_amdgcn_mfma_f32_32x32x16_bf16(k0, qr[d0], s0, 0, 0, 0);
                        s1 = __builtin_amdgcn_mfma_f32_32x32x16_bf16(k1, qr[d0], s1, 0, 0, 0); }
#pragma unroll
                    for (int g = 0; g < 4; ++g) { const f32x4 c0 = *(const LAS f32x4*)(cum + 64 * t + 8 * g + 4 * hi), c1 = *(const LAS f32x4*)(cum + 64 * t + 32 + 8 * g + 4 * hi);
#pragma unroll
                        for (int e = 0; e < 4; ++e) { s0[4 * g + e] = fmaf(s0[4 * g + e], C2, cq - c0[e]); s1[4 * g + e] = fmaf(s1[4 * g + e], C2, cq - c1[e]); } }
                    if (64 * t + 63 > qw0) {
#pragma unroll
                        for (int r = 0; r < 16; ++r) { const int kv = 64 * t + crow(r, hi); if (kv > myq) s0[r] = -INFINITY; if (kv + 32 > myq) s1[r] = -INFINITY; }
                    }
                    const float rm = rowmax32(s0, s1), mnew = fmaxf(mrun, rm), alpha = __builtin_amdgcn_exp2f(mrun - mnew);
                    mrun = mnew;
                    float sacc = 0.f;
#pragma unroll
                    for (int r = 0; r < 16; ++r) { s0[r] = __builtin_amdgcn_exp2f(s0[r] - mnew); s1[r] = __builtin_amdgcn_exp2f(s1[r] - mnew); sacc += s0[r] + s1[r]; }
                    lrun = lrun * alpha + sacc;
                    if (hi == 0) wsf[r32] = alpha;
                    LDS_WAIT();
#pragma unroll
                    for (int r = 0; r < 16; ++r) { const float f = wsf[crow(r, hi)]; o[0][r] *= f; o[1][r] *= f; }
                    u32x4 pw0, pw1, pw2, pw3;
                    pw0 = (u32x4){cvtpk(s0[0], s0[1]), cvtpk(s0[2], s0[3]), cvtpk(s0[4], s0[5]), cvtpk(s0[6], s0[7])};
                    pw1 = (u32x4){cvtpk(s0[8], s0[9]), cvtpk(s0[10], s0[11]), cvtpk(s0[12], s0[13]), cvtpk(s0[14], s0[15])};
                    pw2 = (u32x4){cvtpk(s1[0], s1[1]), cvtpk(s1[2], s1[3]), cvtpk(s1[4], s1[5]), cvtpk(s1[6], s1[7])};
                    pw3 = (u32x4){cvtpk(s1[8], s1[9]), cvtpk(s1[10], s1[11]), cvtpk(s1[12], s1[13]), cvtpk(s1[14], s1[15])};
                    const int vb = (int)(unsigned)(uintptr_t)(lds + AT_V) + ((lane >> 4) & 1) * 32 + (lane & 3) * 8 + (4 * hi + ((lane & 15) >> 2)) * 64;
                    pv_mma(o, vb, __builtin_bit_cast(bf16x8, pw0), __builtin_bit_cast(bf16x8, pw1), __builtin_bit_cast(bf16x8, pw2), __builtin_bit_cast(bf16x8, pw3));
                }
            }
            lrun += __shfl_xor(lrun, 32);
            LDS_WAIT();
            if (hi == 0) wsf[32 + r32] = lrun;
            LDS_WAIT();
            LAS bf16_t* stg = (LAS bf16_t*)(lds + AT_OST) + wave * 2048;
#pragma unroll
            for (int r = 0; r < 16; ++r) { const int orow = crow(r, hi); const float rl = 1.0f / wsf[32 + orow];
                stg[orow * 64 + r32] = (bf16_t)f2bf(o[0][r] * rl); stg[orow * 64 + 32 + r32] = (bf16_t)f2bf(o[1][r] * rl); }
            LDS_WAIT();
#pragma unroll
            for (int i = 0; i < 4; ++i) { const int row = i * 8 + (lane >> 3), ch = lane & 7; const u32x4 vv = *(const LAS u32x4*)(stg + row * 64 + ch * 8);
                *(u32x4*)(U + (rowbase + qw0 + row) * D + h * 64 + ch * 8) = vv; }
            LDS_WAIT();
        }
    }
}

__device__ __forceinline__ void sconv_phase(const Params& p, int tid) {
    const bf16_t* P = (const bf16_t*)(p.ws + WS_P);
    bf16_t* U = (bf16_t*)(p.ws + WS_U);
    const float* cw = p.in[12];
    for (int id = blockIdx.x * NTHR + tid; id < NB * 128 * 128; id += gridDim.x * NTHR) {
        const int c8 = id & 127, tch = (id >> 7) & 127, b = id >> 14, ch0 = c8 * 8, t0 = tch * 16;
        float w0[8], w1[8], w2[8], pm2[8], pm1[8];
#pragma unroll
        for (int e = 0; e < 8; ++e) { w0[e] = cw[ch0 + e]; w1[e] = cw[D + ch0 + e]; w2[e] = cw[2 * D + ch0 + e]; pm2[e] = 0.f; pm1[e] = 0.f; }
#pragma unroll
        for (int tt = -2; tt < 16; ++tt) {
            const int t = t0 + tt;
            float pr[8];
            if (t >= 0) { const bf16_t* row = P + ((size_t)b * SEQ + t) * 3072 + ch0;
                const u32x4 cg_ = *(const u32x4*)(row + 1024), xv = *(const u32x4*)(row + 2048);
#pragma unroll
                for (int e = 0; e < 4; ++e) { pr[2 * e] = bf2f(cg_[e] & 0xffffu) * bf2f(xv[e] & 0xffffu); pr[2 * e + 1] = bf2f(cg_[e] >> 16) * bf2f(xv[e] >> 16); }
            } else {
#pragma unroll
                for (int e = 0; e < 8; ++e) pr[e] = 0.f; }
            if (tt >= 0) { const bf16_t* row = P + ((size_t)b * SEQ + t) * 3072 + ch0; const u32x4 bg = *(const u32x4*)row; float ov[8];
#pragma unroll
                for (int e = 0; e < 4; ++e) { ov[2 * e] = bf2f(bg[e] & 0xffffu) * (w0[2 * e] * pm2[2 * e] + w1[2 * e] * pm1[2 * e] + w2[2 * e] * pr[2 * e]);
                    ov[2 * e + 1] = bf2f(bg[e] >> 16) * (w0[2 * e + 1] * pm2[2 * e + 1] + w1[2 * e + 1] * pm1[2 * e + 1] + w2[2 * e + 1] * pr[2 * e + 1]); }
                u32x4 o; o.x = pk2(ov[0], ov[1]); o.y = pk2(ov[2], ov[3]); o.z = pk2(ov[4], ov[5]); o.w = pk2(ov[6], ov[7]);
                *(u32x4*)(U + ((size_t)b * SEQ + t) * D + ch0) = o; }
#pragma unroll
            for (int e = 0; e < 8; ++e) { pm2[e] = pm1[e]; pm1[e] = pr[e]; }
        }
    }
}

constexpr int LR_XC = 0, LR_A = 36864, LR_B = 69632, LR_AGG = 102400, LR_CARRY = 106496, LR_CW = 106752;
__device__ __forceinline__ float gelu_tanh(float g) { const float u2 = 1.5957691216057308f * (g + 0.044715f * g * g * g); return g / (1.f + __expf(-u2)); }
__device__ __forceinline__ float neg_expm1(float x) {
    const float em = x * (1.f + x * (0.5f + x * (0.16666667f + x * (0.041666668f + x * 0.008333334f))));
    return (x < -0.25f) ? (1.f - __expf(x)) : -em; }
__device__ __forceinline__ float sigmoidf_(float z) { return 1.f / (1.f + __expf(-z)); }
__device__ __forceinline__ void lru_phase(const Params& p, LAS unsigned char* lds, int tid, int lane, int wave) {
    const bf16_t* P = (const bf16_t*)(p.ws + WS_P);
    bf16_t* U = (bf16_t*)(p.ws + WS_U);
    const int r32 = lane & 31, hi = lane >> 5;
    LAS float* LA = (LAS float*)(lds + LR_A); LAS float* LB = (LAS float*)(lds + LR_B);
    LAS float* AGG = (LAS float*)(lds + LR_AGG); LAS float* CARRY = (LAS float*)(lds + LR_CARRY); LAS float* CW = (LAS float*)(lds + LR_CW);
    for (int v = blockIdx.x; v < 256; v += gridDim.x) {
        const int b = v >> 5, n = (v >> 1) & 15, j = v & 1;
        const size_t rowbase = (size_t)b * SEQ;
        __syncthreads();
        if (tid < 256) CW[tid] = p.in[15][(tid >> 6) * D + 64 * n + (tid & 63)];
        else if (tid < 320) CW[tid] = p.in[16][64 * n + (tid - 256)];
        if (tid < 64) CARRY[tid] = 0.f;
        bf16x8 wfa[4], wfx[4];
        { const float* wa = p.in[17] + (size_t)n * 4096 + 32 * j + r32; const float* wx = p.in[19] + (size_t)n * 4096 + 32 * j + r32;
#pragma unroll
          for (int ks = 0; ks < 4; ++ks) { u32x4 ta, tx;
#pragma unroll
              for (int e = 0; e < 4; ++e) { const int k = 16 * ks + 8 * hi + 2 * e;
                  ta[e] = pk2(wa[(size_t)k * 64], wa[(size_t)(k + 1) * 64]); tx[e] = pk2(wx[(size_t)k * 64], wx[(size_t)(k + 1) * 64]); }
              wfa[ks] = __builtin_bit_cast(bf16x8, ta); wfx[ks] = __builtin_bit_cast(bf16x8, tx); } }
        const int chg = 64 * n + 32 * j + r32;
        const float ba = p.in[18][chg], bx = p.in[20][chg];
        float sp; { const float z = -p.in[21][chg]; sp = fmaxf(z, 0.f) + log1pf(__expf(-fabsf(z))); }
        __syncthreads();
        for (int sb = 0; sb < 8; ++sb) {
            const int t0 = sb * 256;
            { const int tl = tid >> 1, kh = tid & 1;
#pragma unroll 1
              for (int c8 = 0; c8 < 4; ++c8) { const int kc = 32 * kh + 8 * c8; float acc[8];
#pragma unroll
                  for (int e = 0; e < 8; ++e) acc[e] = CW[256 + kc + e];
#pragma unroll
                  for (int jj = 0; jj < 4; ++jj) { const int t = t0 + tl - 3 + jj;
                      if (t >= 0) { const u32x4 xv = *(const u32x4*)(P + (rowbase + t) * 2048 + 1024 + 64 * n + kc);
#pragma unroll
                          for (int e = 0; e < 4; ++e) { acc[2 * e] += CW[jj * 64 + kc + 2 * e] * bf2f(xv[e] & 0xffffu); acc[2 * e + 1] += CW[jj * 64 + kc + 2 * e + 1] * bf2f(xv[e] >> 16); } } }
                  u32x4 o; o.x = pk2(acc[0], acc[1]); o.y = pk2(acc[2], acc[3]); o.z = pk2(acc[4], acc[5]); o.w = pk2(acc[6], acc[7]);
                  *(LAS u32x4*)(lds + LR_XC + tl * 144 + kc * 2) = o; } }
            __syncthreads();
            { f32x16 ra, rx;
#pragma unroll
              for (int r = 0; r < 16; ++r) { ra[r] = 0.f; rx[r] = 0.f; }
#pragma unroll
              for (int ks = 0; ks < 4; ++ks) { const bf16x8 af = *(const LAS bf16x8*)(lds + LR_XC + (32 * wave + r32) * 144 + (16 * ks + 8 * hi) * 2);
                  ra = __builtin_amdgcn_mfma_f32_32x32x16_bf16(af, wfa[ks], ra, 0, 0, 0);
                  rx = __builtin_amdgcn_mfma_f32_32x32x16_bf16(af, wfx[ks], rx, 0, 0, 0); }
#pragma unroll
              for (int r = 0; r < 16; ++r) { const int tl = 32 * wave + crow(r, hi);
                  const float xc = bf2f(*(const LAS bf16_t*)(lds + LR_XC + tl * 144 + (32 * j + r32) * 2));
                  const float rg = sigmoidf_(ra[r] + ba), ig = sigmoidf_(rx[r] + bx);
                  const float la = -8.0f * rg * sp, a = __expf(la), mult = sqrtf(neg_expm1(2.0f * la));
                  LA[tl * 32 + r32] = a; LB[tl * 32 + r32] = mult * ig * xc; } }
            __syncthreads();
            { const int ch = tid & 31, tc = tid >> 5;
              float Aa = 1.f, Bv = 0.f;
#pragma unroll 4
              for (int i = 0; i < 16; ++i) { const float a = LA[(16 * tc + i) * 32 + ch], bb = LB[(16 * tc + i) * 32 + ch]; Bv = a * Bv + bb; Aa *= a; }
              AGG[tc * 64 + ch] = Aa; AGG[tc * 64 + 32 + ch] = Bv;
              __syncthreads();
              float hst = CARRY[(sb & 1) * 32 + ch];
              for (int c = 0; c < tc; ++c) hst = AGG[c * 64 + ch] * hst + AGG[c * 64 + 32 + ch];
#pragma unroll 4
              for (int i = 0; i < 16; ++i) { const int tl = 16 * tc + i; hst = LA[tl * 32 + ch] * hst + LB[tl * 32 + ch];
                  const float g = bf2f(P[(rowbase + t0 + tl) * 2048 + 64 * n + 32 * j + ch]);
                  U[(rowbase + t0 + tl) * D + 64 * n + 32 * j + ch] = (bf16_t)f2bf(hst * gelu_tanh(g)); }
              if (tc == 15) CARRY[((sb + 1) & 1) * 32 + ch] = hst; }
            __syncthreads();
        }
    }
}

__global__ void __launch_bounds__(NTHR, 2) fwd_megakernel(Params p) {
    extern __shared__ __attribute__((aligned(16))) unsigned char lds_raw[];
    LAS unsigned char* lds = (LAS unsigned char*)lds_raw;
    cg::grid_group grid = cg::this_grid();
    const int tid0 = threadIdx.x, wave = __builtin_amdgcn_readfirstlane(tid0 >> 6);
    unsigned char* ws = p.ws;
    bf16_t* XN = (bf16_t*)(ws + WS_XN); bf16_t* Ub = (bf16_t*)(ws + WS_U); bf16_t* Pb = (bf16_t*)(ws + WS_P);
    float* Y = (float*)(ws + WS_Y); float* FL = (float*)(ws + WS_FL);
    for (int ph = p.ph_lo; ph < p.ph_hi; ++ph) {
        int tid = tid0; asm volatile("" : "+v"(tid));
        const int lane = tid & 63;
        if (ph == 0) prologue_phase(p, lds, tid, lane, wave);
        else if (ph == NPH - 1) thin_phase(p, 3, 2, -1, 0, p.out, lane, wave);
        else {
            const int i = (ph - 1) / 10, k = (ph - 1) % 10, kind = i % 3, jm = i / 3;
            if (k == 0) { if (i == 0) thin_phase(p, -1, 0, 0, 0, p.in[0], lane, wave); else thin_phase(p, i - 1, 2, i, 0, p.out, lane, wave); }
            else if (k == 3) thin_phase(p, i, 0, i, 1, p.out, lane, wave);
            else if (k == 7) thin_phase(p, i, 1, i, 2, p.out, lane, wave);
            else if (k == 1 || k == 8) { const int s = (k == 1) ? 0 : 1;
                pg8::Gemm g{XN, (const bf16_t*)(ws + WS_WFI) + (size_t)(i * 2 + s) * 2 * FF * D, M, 2 * FF, D}; pg8::StaticOrder S; S.init(M, 2 * FF, (int)gridDim.x, (int)blockIdx.x);
                pg8::EpiSwiglu E{Pb, FF}; pg8::gemm_phase<pg8::EpiSwiglu, pg8::StaticOrder, true, true>(lds, g, S, E); }
            else if (k == 2 || k == 9) { const int s = (k == 2) ? 0 : 1;
                pg8::Gemm g{Pb, (const bf16_t*)(ws + WS_WFO) + (size_t)(i * 2 + s) * D * FF, M, D, FF}; pg8::StaticOrder S; S.init(M, D, (int)gridDim.x, (int)blockIdx.x);
                pg8::EpiF32 E{Y, D}; pg8::gemm_phase<pg8::EpiF32, pg8::StaticOrder, true, true>(lds, g, S, E); }
            else if (k == 4) {
                const bf16_t* W = (kind == 0) ? (const bf16_t*)(ws + WS_FOXI) + (size_t)jm * 3328 * D : (kind == 1) ? (const bf16_t*)(ws + WS_SCI) : (const bf16_t*)(ws + WS_LRI);
                const int N = (kind == 0) ? 3328 : (kind == 1) ? 3072 : 2048, ldp = (kind == 2) ? 2048 : 3072;
                pg8::Gemm g{XN, W, M, N, D}; pg8::StaticOrder S; S.init(M, N, (int)gridDim.x, (int)blockIdx.x);
                pg8::EpiProj E{Pb, ldp, ldp, FL}; pg8::gemm_phase<pg8::EpiProj, pg8::StaticOrder, true, true>(lds, g, S, E); }
            else if (k == 5) {
                if (kind == 0) attn_phase(p, jm, lds, tid, lane, wave);
                else if (kind == 1) sconv_phase(p, tid);
                else lru_phase(p, lds, tid, lane, wave); }
            else {
                const bf16_t* W = (kind == 0) ? (const bf16_t*)(ws + WS_FOXO) + (size_t)jm * D * D : (kind == 1) ? (const bf16_t*)(ws + WS_SCO) : (const bf16_t*)(ws + WS_LRO);
                pg8::Gemm g{Ub, W, M, D, D}; pg8::StaticOrder S; S.init(M, D, (int)gridDim.x, (int)blockIdx.x);
                pg8::EpiF32 E{Y, D}; pg8::gemm_phase<pg8::EpiF32, pg8::StaticOrder, true, true>(lds, g, S, E); }
        }
        if (ph + 1 < p.ph_hi) grid.sync();
    }
}

extern "C" void kernel_launch(void* const* d_in, const int* in_sizes, int n_in, void* d_out, int out_size, void* d_ws, size_t ws_size, hipStream_t stream) {
    static int grid = 0;
    if (grid == 0) {
        if (n_in != 23 || out_size != M * D || ws_size < WS_END) { fprintf(stderr, "kernel_launch: unexpected problem (n_in %d out %d ws %zu)\n", n_in, out_size, ws_size); grid = -1; return; }
        int dev = 0, cus = 0, per_cu = 0;
        hipGetDevice(&dev); hipDeviceGetAttribute(&cus, hipDeviceAttributeMultiprocessorCount, dev);
        hipFuncSetAttribute((const void*)fwd_megakernel, hipFuncAttributeMaxDynamicSharedMemorySize, LDS_BYTES);
        hipOccupancyMaxActiveBlocksPerMultiprocessor(&per_cu, (const void*)fwd_megakernel, NTHR, LDS_BYTES);
        if (per_cu < 1) per_cu = 1;
        (void)hipGetLastError();
        grid = cus;
        if (grid > 256) grid = 256;
    }
    if (grid < 0) return;
    Params p{};
    for (int i = 0; i < 23; ++i) p.in[i] = (const float*)d_in[i];
    p.out = (float*)d_out; p.ws = (unsigned char*)d_ws; p.ph_lo = 0; p.ph_hi = NPH;
    void* args[] = {&p};
    hipError_t e = hipLaunchCooperativeKernel((const void*)fwd_megakernel, dim3(grid), dim3(NTHR), args, LDS_BYTES, stream);
    if (e != hipSuccess) fprintf(stderr, "cooperative launch failed: %s (grid %d)\n", hipGetErrorString(e), grid);
}
```

```cpp
#include <hip/hip_runtime.h>
#include <hip/hip_cooperative_groups.h>
#include <cstdio>
#include <cstdint>
namespace cg = cooperative_groups;

#define LAS __attribute__((address_space(3)))
typedef unsigned short bf16_t;
typedef short bf16x8 __attribute__((ext_vector_type(8)));
typedef short s16x4 __attribute__((ext_vector_type(4)));
typedef float f32x4 __attribute__((ext_vector_type(4)));
typedef float f32x16 __attribute__((ext_vector_type(16)));
typedef unsigned u32x4 __attribute__((ext_vector_type(4)));
typedef unsigned u32x2 __attribute__((ext_vector_type(2)));

constexpr int D = 1024, NB = 8, SEQ = 2048, M = NB * SEQ, FF = 2816, NLAYER = 4, MODW = 9216;
constexpr int NWAVES = 8, NTHR = 512;
constexpr int LDS_BYTES = 147456;
constexpr int NPH = 42;
constexpr int LDS_BARST = LDS_BYTES - 64;
constexpr float RMS_EPS = 1e-6f;
constexpr float L2E = 1.4426950408889634f;

constexpr size_t MiB = 1u << 20;
constexpr size_t WS_MOD = 0;
constexpr size_t WS_BAR = 1536 * 1024;
constexpr size_t WS_FL = 2 * MiB;
constexpr size_t WS_WFI = 4 * MiB;
constexpr size_t WS_WFO = 92 * MiB;
constexpr size_t WS_FOXI = 136 * MiB;
constexpr size_t WS_FOXO = 149 * MiB;
constexpr size_t WS_SCI = 153 * MiB;
constexpr size_t WS_SCO = 159 * MiB;
constexpr size_t WS_LRI = 161 * MiB;
constexpr size_t WS_LRO = 165 * MiB;
constexpr size_t WS_XN = 168 * MiB;
constexpr size_t WS_U = 200 * MiB;
constexpr size_t WS_Y = 232 * MiB;
constexpr size_t WS_P = 296 * MiB;
constexpr size_t WS_END = 392 * MiB;

struct Params { const float* in[23]; float* out; unsigned char* ws; int ph_lo, ph_hi; };

__device__ __forceinline__ unsigned f2bf(float f) { unsigned u = __builtin_bit_cast(unsigned, f); return (u + 0x7fffu + ((u >> 16) & 1u)) >> 16; }
__device__ __forceinline__ unsigned pk2(float lo, float hi) { return f2bf(lo) | (f2bf(hi) << 16); }
__device__ __forceinline__ float bf2f(unsigned h) { return __uint_as_float(h << 16); }
__device__ __forceinline__ int crow(int r, int hi) { return (r & 3) + 8 * (r >> 2) + 4 * hi; }
__device__ __forceinline__ float wave_sum(float v) {
#pragma unroll
    for (int o = 1; o < 64; o <<= 1) v += __shfl_xor(v, o);
    return v;
}
#define LDS_WAIT() asm volatile("s_waitcnt lgkmcnt(0)" ::: "memory")

__device__ __forceinline__ void transpose_item(const float* W, int ld, int K, bf16_t* WT, int k0, int n0, int dst_row0, LAS float* scr, int lane) {
#pragma unroll 8
    for (int i = 0; i < 32; ++i) { const int kk = 2 * i + (lane >> 5); scr[kk * 33 + (lane & 31)] = W[(size_t)(k0 + kk) * ld + n0 + (lane & 31)]; }
    LDS_WAIT(); asm volatile("" ::: "memory");
    const int c = lane & 7;
#pragma unroll
    for (int j = 0; j < 4; ++j) { const int n = (lane >> 3) + 8 * j; const LAS float* s = scr + (8 * c) * 33 + n;
        u32x4 o; o.x = pk2(s[0 * 33], s[1 * 33]); o.y = pk2(s[2 * 33], s[3 * 33]); o.z = pk2(s[4 * 33], s[5 * 33]); o.w = pk2(s[6 * 33], s[7 * 33]);
        *(u32x4*)(WT + (size_t)(dst_row0 + n) * K + k0 + 8 * c) = o; }
    LDS_WAIT(); asm volatile("" ::: "memory");
}
__device__ __forceinline__ void transpose_matrix_item(const float* W, int ld, int K, int N, bf16_t* WT, int mode, int item, LAS float* scr, int lane) {
    const int nblk = N / 32, kb = item / nblk, nb = item % nblk, n0 = 32 * nb;
    int dr = n0;
    if (mode == 1) { if (n0 < FF) dr = (n0 >> 7) * 256 + (n0 & 127); else { const int j = n0 - FF; dr = (j >> 7) * 256 + 128 + (j & 127); } }
    transpose_item(W, ld, K, WT, 64 * kb, n0, dr, scr, lane);
}

__device__ __forceinline__ void prologue_phase(const Params& p, LAS unsigned char* lds, int tid, int lane, int wave) {
    unsigned char* ws = p.ws;
    LAS float* cact = (LAS float*)lds;
    LAS float* part = (LAS float*)(lds + 32768);
    for (int i = tid; i < NB * D; i += NTHR) { const float v = p.in[1][i]; cact[i] = v / (1.f + __expf(-v)); }
    __syncthreads();
    float* MOD = (float*)(ws + WS_MOD);
    for (int task = blockIdx.x; task < NLAYER * MODW / 64; task += gridDim.x) {
        const int gc = task * 64, li = gc / MODW, n0 = gc % MODW;
        const float* W = p.in[2] + (size_t)li * D * MODW + n0 + lane;
        float acc[NB];
#pragma unroll
        for (int b = 0; b < NB; ++b) acc[b] = 0.f;
        const int kbeg = wave * 128;
#pragma unroll 8
        for (int k = 0; k < 128; ++k) { const float w = W[(size_t)(kbeg + k) * MODW];
#pragma unroll
            for (int b = 0; b < NB; ++b) acc[b] += w * cact[b * D + kbeg + k]; }
#pragma unroll
        for (int b = 0; b < NB; ++b) part[(wave * NB + b) * 64 + lane] = acc[b];
        __syncthreads();
        { const int b = tid >> 6; float s = 0.f;
#pragma unroll
          for (int w = 0; w < NWAVES; ++w) s += part[(w * NB + b) * 64 + lane];
          MOD[(size_t)(li * NB + b) * MODW + n0 + lane] = s + p.in[3][li * MODW + n0 + lane]; }
        __syncthreads();
    }
    LAS float* scr = (LAS float*)(lds + 49152 + wave * 8448);
    const int gw = blockIdx.x * NWAVES + wave, NGW = gridDim.x * NWAVES;
    constexpr int I_FI = 16 * 176, I_FO = 44 * 32, I_FXI = 16 * 96, I_SQ = 16 * 32, I_LRI = 16 * 64;
    constexpr int E0 = 8 * I_FI, E1 = E0 + 8 * I_FO, E2 = E1 + 2 * I_FXI, E3 = E2 + 2 * I_SQ, E4 = E3 + I_FXI, E5 = E4 + I_SQ, E6 = E5 + I_LRI, E7 = E6 + I_SQ;
    for (int it = gw; it < E7; it += NGW) {
        if (it < E0) { const int m = it / I_FI, r = it % I_FI; transpose_matrix_item(p.in[6] + (size_t)m * D * 2 * FF, 2 * FF, D, 2 * FF, (bf16_t*)(ws + WS_WFI) + (size_t)m * 2 * FF * D, 1, r, scr, lane); }
        else if (it < E1) { const int q = it - E0, m = q / I_FO, r = q % I_FO; transpose_matrix_item(p.in[7] + (size_t)m * FF * D, D, FF, D, (bf16_t*)(ws + WS_WFO) + (size_t)m * D * FF, 0, r, scr, lane); }
        else if (it < E2) { const int q = it - E1, m = q / I_FXI, r = q % I_FXI; transpose_matrix_item(p.in[8] + (size_t)m * D * 3088, 3088, D, 3072, (bf16_t*)(ws + WS_FOXI) + (size_t)m * 3328 * D, 0, r, scr, lane); }
        else if (it < E3) { const int q = it - E2, m = q / I_SQ, r = q % I_SQ; transpose_matrix_item(p.in[10] + (size_t)m * D * D, D, D, D, (bf16_t*)(ws + WS_FOXO) + (size_t)m * D * D, 0, r, scr, lane); }
        else if (it < E4) { transpose_matrix_item(p.in[11], 3072, D, 3072, (bf16_t*)(ws + WS_SCI), 0, it - E3, scr, lane); }
        else if (it < E5) { transpose_matrix_item(p.in[13], D, D, D, (bf16_t*)(ws + WS_SCO), 0, it - E4, scr, lane); }
        else if (it < E6) { transpose_matrix_item(p.in[14], 2048, D, 2048, (bf16_t*)(ws + WS_LRI), 0, it - E5, scr, lane); }
        else { transpose_matrix_item(p.in[22], D, D, D, (bf16_t*)(ws + WS_LRO), 0, it - E6, scr, lane); }
    }
    const int gt = blockIdx.x * NTHR + tid, NGT = gridDim.x * NTHR;
    for (int e = gt; e < 2 * 256 * 128; e += NGT) {
        const int m = e / (256 * 128), r = (e / 128) % 256, kc = e % 128;
        u32x4 o = (u32x4){0u, 0u, 0u, 0u};
        if (r < 16) { const float* W = p.in[8] + (size_t)m * D * 3088 + 3072 + r; const int k = kc * 8;
            o.x = pk2(W[(size_t)(k + 0) * 3088], W[(size_t)(k + 1) * 3088]); o.y = pk2(W[(size_t)(k + 2) * 3088], W[(size_t)(k + 3) * 3088]);
            o.z = pk2(W[(size_t)(k + 4) * 3088], W[(size_t)(k + 5) * 3088]); o.w = pk2(W[(size_t)(k + 6) * 3088], W[(size_t)(k + 7) * 3088]); }
        *(u32x4*)((bf16_t*)(ws + WS_FOXI) + (size_t)m * 3328 * D + (size_t)(3072 + r) * D + kc * 8) = o;
    }
}

__device__ __forceinline__ void thin_phase(const Params& p, int ip, int sp, int in_, int sn, const float* xin, int lane, int wave) {
    const float* MOD = (const float*)(p.ws + WS_MOD);
    const float* Y = (const float*)(p.ws + WS_Y);
    bf16_t* XN = (bf16_t*)(p.ws + WS_XN);
    const int gw = blockIdx.x * NWAVES + wave, NGW = gridDim.x * NWAVES;
    for (int m = gw; m < M; m += NGW) {
        const int b = m >> 11;
        f32x4 x[4];
#pragma unroll
        for (int j = 0; j < 4; ++j) x[j] = *(const f32x4*)(xin + (size_t)m * D + 4 * lane + 256 * j);
        if (ip >= 0) {
            f32x4 y[4]; float ss = 0.f;
#pragma unroll
            for (int j = 0; j < 4; ++j) { y[j] = *(const f32x4*)(Y + (size_t)m * D + 4 * lane + 256 * j); ss += (y[j].x * y[j].x + y[j].y * y[j].y) + (y[j].z * y[j].z + y[j].w * y[j].w); }
            const float rstd = rsqrtf(wave_sum(ss) * (1.f / D) + RMS_EPS) * (sp == 1 ? 1.0f : 0.5f);
            const float* gate = MOD + (size_t)(ip * NB + b) * MODW + sp * 3072 + 2048;
            const float* npost = p.in[5] + (ip * 3 + sp) * D;
#pragma unroll
            for (int j = 0; j < 4; ++j) { const f32x4 g = *(const f32x4*)(gate + 4 * lane + 256 * j), n = *(const f32x4*)(npost + 4 * lane + 256 * j); x[j] = x[j] + g * (y[j] * rstd) * n; }
        }
        if (ip >= 0 || xin != p.out) {
#pragma unroll
            for (int j = 0; j < 4; ++j) *(f32x4*)(p.out + (size_t)m * D + 4 * lane + 256 * j) = x[j];
        }
        if (in_ >= 0) {
            float ss = 0.f;
#pragma unroll
            for (int j = 0; j < 4; ++j) ss += (x[j].x * x[j].x + x[j].y * x[j].y) + (x[j].z * x[j].z + x[j].w * x[j].w);
            const float rstd = rsqrtf(wave_sum(ss) * (1.f / D) + RMS_EPS);
            const float* shift = MOD + (size_t)(in_ * NB + b) * MODW + sn * 3072;
            const float* scale = shift + 1024;
            const float* npre = p.in[4] + (in_ * 3 + sn) * D;
#pragma unroll
            for (int j = 0; j < 4; ++j) { const f32x4 sh = *(const f32x4*)(shift + 4 * lane + 256 * j), sc = *(const f32x4*)(scale + 4 * lane + 256 * j), n = *(const f32x4*)(npre + 4 * lane + 256 * j);
                const f32x4 v = (x[j] * rstd) * n * (sc + 1.0f) + sh;
                u32x2 o; o.x = pk2(v.x, v.y); o.y = pk2(v.z, v.w);
                *(u32x2*)(XN + (size_t)m * D + 4 * lane + 256 * j) = o; }
        }
    }
}

namespace pg8 {
#define PG8_LAS __attribute__((address_space(3)))
typedef unsigned short bf16_t;
typedef short bf16x8 __attribute__((ext_vector_type(8)));
typedef float f32x4 __attribute__((ext_vector_type(4)));
typedef unsigned u32x4 __attribute__((ext_vector_type(4)));
constexpr int BM = 256, BK = 64, HALF = 128, HTB = HALF * BK * 2  , STAGE_BYTES = 8 * HTB, NXCD = 8, WGM = 8;

__host__ __device__ __forceinline__ int lds_byte(int r, int c) { const int st = (r >> 4) * 2 + (c >> 5), rr = r & 15, cc = c & 31, ob = rr * 64 + cc * 2; return st * 1024 + (ob ^ (((ob >> 9) & 1) << 5)); }
__host__ __device__ __forceinline__ void stage_rc(int b, int& R, int& C) { const int st = b / 1024, sb = b % 1024, swz = sb ^ (((sb >> 9) & 1) << 5); R = (st >> 1) * 16 + swz / 64; C = (st & 1) * 32 + (swz % 64) / 2; }
__host__ __device__ __forceinline__ int perm32(int rho) { const int n = rho >> 4, i = rho & 15; return 8 * (i >> 2) + 4 * n + (i & 3); }

struct Unit { int pm, pn; };
struct Gemm { const bf16_t* A; const bf16_t* Bt; int M, N, K; };

struct StaticOrder {
    int nM, nN, nwg, G, c;
    __host__ __device__ void init(int M, int N, int G_, int c_) { nM = M / BM; nN = N / BM; nwg = nM * nN; G = G_; c = c_; }
    __host__ __device__ bool next(int i, Unit& u) const {
        const long L = (long)i * G + c; if (L >= nwg) return false;
        int wgid = (int)L; { const int q = nwg / NXCD, r = nwg % NXCD, xcd = wgid % NXCD, off = wgid / NXCD; wgid = (xcd < r ? xcd * (q + 1) : r * (q + 1) + (xcd - r) * q) + off; }
        const int nig = WGM * nN, gid = wgid / nig, fm = gid * WGM, gsz = (nM - fm) < WGM ? (nM - fm) : WGM;
        u.pm = fm + ((wgid % nig) % gsz); u.pn = (wgid % nig) / gsz; return true;
    }
    __device__ __forceinline__ void a_ready(const Unit&) const {}
    __device__ __forceinline__ void done(const Unit&) const {}
};

__device__ __forceinline__ unsigned cvt_pk_bf16(float lo, float hi) { unsigned r; asm volatile("v_cvt_pk_bf16_f32 %0, %1, %2" : "=v"(r) : "v"(lo), "v"(hi)); return r; }
typedef float f32x2 __attribute__((ext_vector_type(2)));

struct EpiSwiglu {
    static constexpr bool PERM = true, AFTER_DRAIN = false;
    bf16_t* H; int ldh;
    __device__ __forceinline__ void operator()(const f32x4 (&acc)[2][2][4][2], const Unit& u, int wr, int wc, int fr, int fq) const {
        const int row0 = u.pm * BM + wr * 64 + fr, col0 = u.pn * 128 + wc * 32 + 8 * fq;
#pragma unroll
        for (int ai = 0; ai < 2; ++ai)
#pragma unroll
            for (int m = 0; m < 4; ++m) { bf16_t* rowp = H + (size_t)(row0 + ai * HALF + m * 16) * ldh + col0; float h[8];
#pragma unroll
                for (int n = 0; n < 2; ++n)
#pragma unroll
                    for (int e = 0; e < 4; ++e) { const float g = acc[ai][0][m][n][e], uu = acc[ai][1][m][n][e]; h[4 * n + e] = g * uu * __builtin_amdgcn_rcpf(1.f + __expf(-g)); }
                u32x4 w; w.x = cvt_pk_bf16(h[0], h[1]); w.y = cvt_pk_bf16(h[2], h[3]); w.z = cvt_pk_bf16(h[4], h[5]); w.w = cvt_pk_bf16(h[6], h[7]);
                *(u32x4*)rowp = w; }
    }
};
struct EpiF32 {
    static constexpr bool PERM = true, AFTER_DRAIN = false;
    float* Y; int ldc;
    __device__ __forceinline__ void operator()(const f32x4 (&acc)[2][2][4][2], const Unit& u, int wr, int wc, int fr, int fq) const {
        const int row0 = u.pm * BM + wr * 64 + fr, col0 = u.pn * BM + wc * 32 + 8 * fq;
#pragma unroll
        for (int ai = 0; ai < 2; ++ai)
#pragma unroll
            for (int m = 0; m < 4; ++m) { float* rowp = Y + (size_t)(row0 + ai * HALF + m * 16) * ldc + col0;
#pragma unroll
                for (int bj = 0; bj < 2; ++bj) { *(f32x4*)(rowp + bj * HALF) = acc[ai][bj][m][0]; *(f32x4*)(rowp + bj * HALF + 4) = acc[ai][bj][m][1]; } }
    }
};
struct EpiProj {
    static constexpr bool PERM = true, AFTER_DRAIN = false;
    bf16_t* P; int ldp; int ncol_main; float* FL;
    __device__ __forceinline__ void operator()(const f32x4 (&acc)[2][2][4][2], const Unit& u, int wr, int wc, int fr, int fq) const {
        const int row0 = u.pm * BM + wr * 64 + fr, colt = u.pn * BM;
        if (colt < ncol_main) {
            const int col0 = colt + wc * 32 + 8 * fq;
#pragma unroll
            for (int ai = 0; ai < 2; ++ai)
#pragma unroll
                for (int m = 0; m < 4; ++m) { bf16_t* rowp = P + (size_t)(row0 + ai * HALF + m * 16) * ldp + col0;
#pragma unroll
                    for (int bj = 0; bj < 2; ++bj) { const f32x4 v0 = acc[ai][bj][m][0], v1 = acc[ai][bj][m][1];
                        u32x4 w; w.x = cvt_pk_bf16(v0[0], v0[1]); w.y = cvt_pk_bf16(v0[2], v0[3]); w.z = cvt_pk_bf16(v1[0], v1[1]); w.w = cvt_pk_bf16(v1[2], v1[3]);
                        *(u32x4*)(rowp + bj * HALF) = w; } }
        } else if (wc == 0 && fq < 2) {
#pragma unroll
            for (int ai = 0; ai < 2; ++ai)
#pragma unroll
                for (int m = 0; m < 4; ++m) { float* rowp = FL + (size_t)(row0 + ai * HALF + m * 16) * 16 + 8 * fq;
                    *(f32x4*)rowp = acc[ai][0][m][0]; *(f32x4*)(rowp + 4) = acc[ai][0][m][1]; }
        }
    }
};
template <class Epi, class Sched, bool ALIGN_EPI = false, bool SP2 = false>
__device__ __forceinline__ void gemm_phase(PG8_LAS unsigned char* lds, const Gemm g, const Sched& S, const Epi& E) {
    int tid_ = threadIdx.x; asm volatile("" : "+v"(tid_));
    const int tid = tid_, wid = __builtin_amdgcn_readfirstlane(tid >> 6), lane = tid & 63, wr = wid >> 2, wc = wid & 3, fr = lane & 15, fq = lane >> 4;
    const int K = g.K, nt = K / BK;
    unsigned voffA[2], voffB[2];
#pragma unroll
    for (int i = 0; i < 2; ++i) { int R, C; stage_rc(tid * 16 + i * 8192, R, C); const int Rb = Epi::PERM ? ((R & ~31) + perm32(R & 31)) : R;
        voffA[i] = (unsigned)(R * K + C) * 2u; voffB[i] = (unsigned)(Rb * K + C) * 2u; }
    const size_t kstep = (size_t)(BK * 2);
    const size_t hstep = (size_t)HALF * K * 2;
    const size_t tstep = 2 * hstep;
    const unsigned ldsw = (unsigned)wid * 1024u;
    const int aoff = lds_byte(wr * 64 + fr, fq * 8), boff = lds_byte(wc * 32 + fr, fq * 8);
#define PG8_SA(b, h) (((b) * 2 + (h)) * HTB)
#define PG8_SB(b, h) ((4 + (b) * 2 + (h)) * HTB)
#define PG8_STAGE(bufoff, gbase, voff) do { _Pragma("unroll") for (int _i = 0; _i < 2; ++_i) \
        __builtin_amdgcn_global_load_lds((const unsigned*)((const char*)(gbase) + (voff)[_i]), (PG8_LAS unsigned*)(lds + (bufoff) + ldsw + _i * 8192), 16, 0, 0); } while (0)
#define PG8_LDA(dst, b, h) do { _Pragma("unroll") for (int m = 0; m < 4; ++m) _Pragma("unroll") for (int k = 0; k < 2; ++k) dst[m][k] = *(const PG8_LAS bf16x8*)(lds + PG8_SA(b, h) + aoff + m * 2048 + k * 1024); } while (0)
#define PG8_LDB(dst, b, h) do { _Pragma("unroll") for (int n = 0; n < 2; ++n) _Pragma("unroll") for (int k = 0; k < 2; ++k) dst[n][k] = *(const PG8_LAS bf16x8*)(lds + PG8_SB(b, h) + boff + n * 2048 + k * 1024); } while (0)
#define PG8_MMA(ai, bj, At, Bt) do { __builtin_amdgcn_s_setprio(1); _Pragma("unroll") for (int m = 0; m < 4; ++m) _Pragma("unroll") for (int n = 0; n < 2; ++n) _Pragma("unroll") for (int k = 0; k < 2; ++k) \
        acc[ai][bj][m][n] = __builtin_amdgcn_mfma_f32_16x16x32_bf16(Bt[n][k], At[m][k], acc[ai][bj][m][n], 0, 0, 0); __builtin_amdgcn_s_setprio(0); } while (0)
#define PG8_WAIT_V(n) asm volatile("s_waitcnt vmcnt(" #n ")" ::: "memory")
#define PG8_WAIT_L(n) asm volatile("s_waitcnt lgkmcnt(" #n ")" ::: "memory")
#define PG8_BAR __builtin_amdgcn_s_barrier()
#define PG8_SCHED __builtin_amdgcn_sched_barrier(0)
    Unit cur, nxt; int ui = 0;
    if (!S.next(0, cur)) return;
    f32x4 acc[2][2][4][2];
#pragma unroll
    for (int a = 0; a < 2; ++a)
#pragma unroll
        for (int b = 0; b < 2; ++b)
#pragma unroll
            for (int m = 0; m < 4; ++m)
#pragma unroll
                for (int n = 0; n < 2; ++n) acc[a][b][m][n] = (f32x4){0.f, 0.f, 0.f, 0.f};
    bf16x8 At[4][2], B0[2][2], B1[2][2];
    const char* cA = (const char*)g.A + (size_t)cur.pm * tstep; const char* cB = (const char*)g.Bt + (size_t)cur.pn * tstep;
    S.a_ready(cur);
    if constexpr (SP2) {
        PG8_STAGE(PG8_SB(0, 0), cB, voffB); PG8_STAGE(PG8_SB(0, 1), cB + hstep, voffB); PG8_STAGE(PG8_SA(0, 0), cA, voffA); PG8_STAGE(PG8_SA(0, 1), cA + hstep, voffA);
        if (wr == 1) PG8_BAR;
        PG8_WAIT_V(2); PG8_BAR;
        PG8_STAGE(PG8_SB(1, 0), cB + kstep, voffB); PG8_STAGE(PG8_SA(1, 0), cA + kstep, voffA); PG8_STAGE(PG8_SB(1, 1), cB + hstep + kstep, voffB);
        PG8_WAIT_V(6); PG8_BAR;
    } else {
        PG8_STAGE(PG8_SB(0, 0), cB, voffB); PG8_STAGE(PG8_SA(0, 0), cA, voffA); PG8_STAGE(PG8_SB(0, 1), cB + hstep, voffB); PG8_STAGE(PG8_SA(0, 1), cA + hstep, voffA);
        if (wr == 1) PG8_BAR;
        PG8_WAIT_V(4); PG8_BAR;
        PG8_STAGE(PG8_SB(1, 0), cB + kstep, voffB); PG8_STAGE(PG8_SA(1, 0), cA + kstep, voffA); PG8_STAGE(PG8_SB(1, 1), cB + hstep + kstep, voffB);
        PG8_WAIT_V(6); PG8_BAR;
    }
    for (;;) {
        const bool has_next = S.next(ui + 1, nxt);
        const char* nA = has_next ? (const char*)g.A + (size_t)nxt.pm * tstep : cA; const char* nB = has_next ? (const char*)g.Bt + (size_t)nxt.pn * tstep : cB;
        for (int t = 0; t < nt; t += 2) {
            const bool last = (t == nt - 2);
            const char* a1 = cA + (size_t)(t + 1) * kstep;
            const char* a2 = last ? nA : cA + (size_t)(t + 2) * kstep; const char* b2 = last ? nB : cB + (size_t)(t + 2) * kstep;
            const char* a3 = a2 + kstep; const char* b3 = b2 + kstep;
            if (last && has_next) S.a_ready(nxt);
            if constexpr (SP2) {
            PG8_LDB(B0, 0, 0); PG8_LDB(B1, 0, 1); PG8_SCHED; PG8_LDA(At, 0, 0); PG8_STAGE(PG8_SA(1, 1), a1 + hstep, voffA);
            PG8_WAIT_V(8); PG8_WAIT_L(0); PG8_BAR; PG8_MMA(0, 0, At, B0); PG8_MMA(0, 1, At, B1); PG8_BAR; PG8_SCHED;
            PG8_LDA(At, 0, 1); PG8_STAGE(PG8_SB(0, 0), b2, voffB); PG8_STAGE(PG8_SB(0, 1), b2 + hstep, voffB); PG8_STAGE(PG8_SA(0, 0), a2, voffA);
            PG8_WAIT_V(8); PG8_WAIT_L(0); PG8_BAR; PG8_MMA(1, 0, At, B0); PG8_MMA(1, 1, At, B1); PG8_BAR; PG8_SCHED;
            PG8_LDB(B0, 1, 0); PG8_LDB(B1, 1, 1); PG8_SCHED; PG8_LDA(At, 1, 0); PG8_STAGE(PG8_SA(0, 1), a2 + hstep, voffA);
            PG8_WAIT_V(8); PG8_WAIT_L(0); PG8_BAR; PG8_MMA(0, 0, At, B0); PG8_MMA(0, 1, At, B1); PG8_BAR; PG8_SCHED;
            PG8_LDA(At, 1, 1); PG8_STAGE(PG8_SB(1, 0), b3, voffB); PG8_STAGE(PG8_SB(1, 1), b3 + hstep, voffB); PG8_STAGE(PG8_SA(1, 0), a3, voffA);
            PG8_WAIT_V(8); PG8_WAIT_L(0); PG8_BAR; PG8_MMA(1, 0, At, B0); PG8_MMA(1, 1, At, B1); PG8_BAR; PG8_SCHED;
            } else {
            PG8_LDB(B0, 0, 0); PG8_SCHED; PG8_LDA(At, 0, 0); PG8_STAGE(PG8_SA(1, 1), a1 + hstep, voffA);
            PG8_WAIT_L(8); PG8_BAR; PG8_WAIT_L(0); PG8_MMA(0, 0, At, B0); PG8_BAR; PG8_SCHED;
            PG8_LDB(B1, 0, 1); PG8_STAGE(PG8_SB(0, 0), b2, voffB);
            PG8_BAR; PG8_WAIT_L(0); PG8_MMA(0, 1, At, B1); PG8_BAR;
            PG8_LDA(At, 0, 1); PG8_STAGE(PG8_SA(0, 0), a2, voffA);
            PG8_BAR; PG8_WAIT_L(0); PG8_MMA(1, 0, At, B0); PG8_BAR; PG8_SCHED;
            PG8_STAGE(PG8_SB(0, 1), b2 + hstep, voffB);
            PG8_WAIT_V(6); PG8_BAR; PG8_MMA(1, 1, At, B1); PG8_BAR;
            PG8_LDB(B0, 1, 0); PG8_SCHED; PG8_LDA(At, 1, 0); PG8_STAGE(PG8_SA(0, 1), a2 + hstep, voffA);
            PG8_WAIT_L(8); PG8_BAR; PG8_WAIT_L(0); PG8_MMA(0, 0, At, B0); PG8_BAR; PG8_SCHED;
            PG8_LDB(B1, 1, 1); PG8_STAGE(PG8_SB(1, 0), b3, voffB);
            PG8_BAR; PG8_WAIT_L(0); PG8_MMA(0, 1, At, B1); PG8_BAR;
            PG8_LDA(At, 1, 1); PG8_STAGE(PG8_SA(1, 0), a3, voffA);
            PG8_BAR; PG8_WAIT_L(0); PG8_MMA(1, 0, At, B0); PG8_BAR; PG8_SCHED;
            PG8_STAGE(PG8_SB(1, 1), b3 + hstep, voffB);
            PG8_WAIT_V(6); PG8_BAR; PG8_MMA(1, 1, At, B1); PG8_BAR;
            }
        }
        if constexpr (ALIGN_EPI) { if (wr == 0) PG8_BAR; }
        if constexpr (!Epi::AFTER_DRAIN) { E(acc, cur, wr, wc, fr, fq); S.done(cur); }
        if (!has_next) break;
#pragma unroll
        for (int a = 0; a < 2; ++a)
#pragma unroll
            for (int b = 0; b < 2; ++b)
#pragma unroll
                for (int m = 0; m < 4; ++m)
#pragma unroll
                    for (int n = 0; n < 2; ++n) acc[a][b][m][n] = (f32x4){0.f, 0.f, 0.f, 0.f};
        cur = nxt; cA = nA; cB = nB; ++ui;
        if constexpr (ALIGN_EPI) { if (wr == 1) PG8_BAR; }
    }
    PG8_WAIT_V(0);
    if constexpr (!ALIGN_EPI) { if (wr == 0) PG8_BAR; }
    PG8_BAR;
    if constexpr (Epi::AFTER_DRAIN) { E.fused(acc, cur, wr, wc, fr, fq, lds, wid, lane); S.done(cur); }
#undef PG8_SA
#undef PG8_SB
#undef PG8_STAGE
#undef PG8_LDA
#undef PG8_LDB
#undef PG8_MMA
#undef PG8_WAIT_V
#undef PG8_WAIT_L
#undef PG8_BAR
#undef PG8_SCHED
}
}

constexpr int AT_K = 0, AT_V = 8192, AT_CUM = 16384, AT_WS = 24576, AT_OST = 26624, AT_SCAN = 59392;
__device__ __forceinline__ float max3f(float a, float b, float c) { return fmaxf(fmaxf(a, b), c); }
__device__ __forceinline__ float rowmax32(const f32x16& p0, const f32x16& p1) {
    float a = max3f(p0[0], p0[1], p1[0]), b = max3f(p0[2], p0[3], p1[1]); a = max3f(a, p1[2], p1[3]);
#pragma unroll
    for (int r = 4; r < 16; r += 4) { a = max3f(a, p0[r], p0[r + 1]); b = max3f(b, p0[r + 2], p0[r + 3]); a = max3f(a, p1[r], p1[r + 1]); b = max3f(b, p1[r + 2], p1[r + 3]); }
    const float m = fmaxf(a, b);
    return fmaxf(m, __shfl_xor(m, 32));
}
__device__ __forceinline__ unsigned cvtpk(float lo, float hi) { return pk2(lo, hi); }
__device__ __forceinline__ void pv_mma(f32x16* o, int vb, bf16x8 pa0, bf16x8 pa1, bf16x8 pa2, bf16x8 pa3) {
#pragma unroll
    for (int d0 = 0; d0 < 2; ++d0) { s16x4 lo[4], hi[4];
#pragma unroll
        for (int ks = 0; ks < 4; ++ks) {
            asm volatile("ds_read_b64_tr_b16 %0,%1 offset:%c2" : "=&v"(lo[ks]) : "v"(vb), "i"(d0 * 4096 + ks * 1024) : "memory");
            asm volatile("ds_read_b64_tr_b16 %0,%1 offset:%c2" : "=&v"(hi[ks]) : "v"(vb), "i"(d0 * 4096 + ks * 1024 + 512) : "memory"); }
        asm volatile("s_waitcnt lgkmcnt(0)" ::: "memory"); __builtin_amdgcn_sched_barrier(0);
#define PK(k) (bf16x8){lo[k][0], lo[k][1], lo[k][2], lo[k][3], hi[k][0], hi[k][1], hi[k][2], hi[k][3]}
        o[d0] = __builtin_amdgcn_mfma_f32_32x32x16_bf16(pa0, PK(0), o[d0], 0, 0, 0);
        o[d0] = __builtin_amdgcn_mfma_f32_32x32x16_bf16(pa1, PK(1), o[d0], 0, 0, 0);
        o[d0] = __builtin_amdgcn_mfma_f32_32x32x16_bf16(pa2, PK(2), o[d0], 0, 0, 0);
        o[d0] = __builtin_amdgcn_mfma_f32_32x32x16_bf16(pa3, PK(3), o[d0], 0, 0, 0);
#undef PK
    }
}

__device__ __forceinline__ void attn_phase(const Params& p, int jf, LAS unsigned char* lds, int tid, int lane, int wave) {
    const bf16_t* P = (const bf16_t*)(p.ws + WS_P);
    const float* FL = (const float*)(p.ws + WS_FL);
    bf16_t* U = (bf16_t*)(p.ws + WS_U);
    const int r32 = lane & 31, hi = lane >> 5;
    LAS float* cum = (LAS float*)(lds + AT_CUM);
    LAS float* wsf = (LAS float*)(lds + AT_WS) + wave * 64;
    LAS float* scanw = (LAS float*)(lds + AT_SCAN);
    const float C2 = 0.125f * L2E;
    for (int v = blockIdx.x; v < 256; v += gridDim.x) {
        const int bh = v >> 1, b = bh >> 4, h = bh & 15;
        const size_t rowbase = (size_t)b * SEQ;
        __syncthreads();
        { const float bf = p.in[9][jf * 16 + h]; float ls[4]; float run = 0.f;
#pragma unroll
          for (int i = 0; i < 4; ++i) { const float z = FL[(rowbase + 4 * tid + i) * 16 + h] + bf;
              const float lsg = (z >= 0.f) ? -log1pf(__expf(-z)) : (z - log1pf(__expf(z))); run += lsg; ls[i] = run; }
          float inc = run;
#pragma unroll
          for (int o = 1; o < 64; o <<= 1) { const float t = __shfl_up(inc, o); if (lane >= o) inc += t; }
          if (lane == 63) scanw[wave] = inc;
          __syncthreads();
          float off = inc - run;
          for (int w = 0; w < wave; ++w) off += scanw[w];
#pragma unroll
          for (int i = 0; i < 4; ++i) cum[4 * tid + i] = (off + ls[i]) * L2E;
        }
        __syncthreads();
        for (int ui = 0; ui < 4; ++ui) {
            const int qb = (v & 1) ? ((ui == 0) ? 1 : (ui == 1) ? 6 : (ui == 2) ? 3 : 4) : ((ui == 0) ? 0 : (ui == 1) ? 7 : (ui == 2) ? 2 : 5);
            const int q0 = qb * 256, qw0 = q0 + 32 * wave, myq = qw0 + r32;
            bf16x8 qr[4];
#pragma unroll
            for (int d0 = 0; d0 < 4; ++d0) qr[d0] = *(const bf16x8*)(P + (rowbase + myq) * 3072 + h * 64 + d0 * 16 + hi * 8);
            const float cq = cum[myq];
            float mrun = -1e30f, lrun = 0.f; f32x16 o[2];
#pragma unroll
            for (int r = 0; r < 16; ++r) { o[0][r] = 0.f; o[1][r] = 0.f; }
            const int NT = (q0 + 256) / 64;
            for (int t = 0; t < NT; ++t) {
                __syncthreads();
                { const u32x4 kv = *(const u32x4*)(P + (rowbase + 64 * t + lane) * 3072 + 1024 + h * 64 + 8 * wave);
                  *(LAS u32x4*)(lds + AT_K + wave * 1024 + lane * 16) = kv;
                  const int vr = 16 * (wave & 3) + (lane >> 2), vc = (wave >> 2) * 32 + (lane & 3) * 8;
                  const u32x4 vv = *(const u32x4*)(P + (rowbase + 64 * t + vr) * 3072 + 2048 + h * 64 + vc);
                  *(LAS u32x4*)(lds + AT_V + wave * 1024 + lane * 16) = vv; }
                __syncthreads();
                if (64 * t <= qw0 + 31) {
                    f32x16 s0, s1;
#pragma unroll
                    for (int r = 0; r < 16; ++r) { s0[r] = 0.f; s1[r] = 0.f; }
                    const LAS unsigned char* kb = lds + AT_K + hi * 1024 + r32 * 16;
#pragma unroll
                    for (int d0 = 0; d0 < 4; ++d0) {
                        const bf16x8 k0 = *(const LAS bf16x8*)(kb + d0 * 2048), k1 = *(const LAS bf16x8*)(kb + d0 * 2048 + 512);
                        s0 = __builtin_amdgcn_mfma_f32_32x32x16_bf16(k0, qr[d0], s0, 0, 0, 0);
                        s1 = __builtin_amdgcn_mfma_f32_32x32x16_bf16(k1, qr[d0], s1, 0, 0, 0); }
#pragma unroll
                    for (int g = 0; g < 4; ++g) { const f32x4 c0 = *(const LAS f32x4*)(cum + 64 * t + 8 * g + 4 * hi), c1 = *(const LAS f32x4*)(cum + 64 * t + 32 + 8 * g + 4 * hi);
#pragma unroll
                        for (int e = 0; e < 4; ++e) { s0[4 * g + e] = fmaf(s0[4 * g + e], C2, cq - c0[e]); s1[4 * g + e] = fmaf(s1[4 * g + e], C2, cq - c1[e]); } }
                    if (64 * t + 63 > qw0) {
#pragma unroll
                        for (int r = 0; r < 16; ++r) { const int kv = 64 * t + crow(r, hi); if (kv > myq) s0[r] = -INFINITY; if (kv + 32 > myq) s1[r] = -INFINITY; }
                    }
                    const float rm = rowmax32(s0, s1), mnew = fmaxf(mrun, rm), alpha = __builtin_amdgcn_exp2f(mrun - mnew);
                    mrun = mnew;
                    float sacc = 0.f;
#pragma unroll
                    for (int r = 0; r < 16; ++r) { s0[r] = __builtin_amdgcn_exp2f(s0[r] - mnew); s1[r] = __builtin_amdgcn_exp2f(s1[r] - mnew); sacc += s0[r] + s1[r]; }
                    lrun = lrun * alpha + sacc;
                    if (hi == 0) wsf[r32] = alpha;
                    LDS_WAIT();
#pragma unroll
                    for (int r = 0; r < 16; ++r) { const float f = wsf[crow(r, hi)]; o[0][r] *= f; o[1][r] *= f; }
                    u32x4 pw0, pw1, pw2, pw3;
                    pw0 = (u32x4){cvtpk(s0[0], s0[1]), cvtpk(s0[2], s0[3]), cvtpk(s0[4], s0[5]), cvtpk(s0[6], s0[7])};
                    pw1 = (u32x4){cvtpk(s0[8], s0[9]), cvtpk(s0[10], s0[11]), cvtpk(s0[12], s0[13]), cvtpk(s0[14], s0[15])};
                    pw2 = (u32x4){cvtpk(s1[0], s1[1]), cvtpk(s1[2], s1[3]), cvtpk(s1[4], s1[5]), cvtpk(s1[6], s1[7])};
                    pw3 = (u32x4){cvtpk(s1[8], s1[9]), cvtpk(s1[10], s1[11]), cvtpk(s1[12], s1[13]), cvtpk(s1[14], s1[15])};
                    const int vb = (int)(unsigned)(uintptr_t)(lds + AT_V) + ((lane >> 4) & 1) * 32 + (lane & 3) * 8 + (4 * hi + ((lane & 15) >> 2)) * 64;
                    pv_mma(o, vb, __builtin_bit_cast(bf16x8, pw0), __builtin_bit_cast(bf16x8, pw1), __builtin_bit_cast(bf16x8, pw2), __builtin_bit_cast(bf16x8, pw3));
                }
            }
            lrun += __shfl_xor(lrun, 32);
            LDS_WAIT();
            if (hi == 0) wsf[32 + r32] = lrun;
            LDS_WAIT();
            LAS bf16_t* stg = (LAS bf16_t*)(lds + AT_OST) + wave * 2048;
#pragma unroll
            for (int r = 0; r < 16; ++r) { const int orow = crow(r, hi); const float rl = 1.0f / wsf[32 + orow];
                stg[orow * 64 + r32] = (bf16_t)f2bf(o[0][r] * rl); stg[orow * 64 + 32 + r32] = (bf16_t)f2bf(o[1][r] * rl); }
            LDS_WAIT();
#pragma unroll
            for (int i = 0; i < 4; ++i) { const int row = i * 8 + (lane >> 3), ch = lane & 7; const u32x4 vv = *(const LAS u32x4*)(stg + row * 64 + ch * 8);
                *(u32x4*)(U + (rowbase + qw0 + row) * D + h * 64 + ch * 8) = vv; }
            LDS_WAIT();
        }
    }
}

__device__ __forceinline__ void sconv_phase(const Params& p, int tid) {
    const bf16_t* P = (const bf16_t*)(p.ws + WS_P);
    bf16_t* U = (bf16_t*)(p.ws + WS_U);
    const float* cw = p.in[12];
    for (int id = blockIdx.x * NTHR + tid; id < NB * 128 * 128; id += gridDim.x * NTHR) {
        const int c8 = id & 127, tch = (id >> 7) & 127, b = id >> 14, ch0 = c8 * 8, t0 = tch * 16;
        float w0[8], w1[8], w2[8], pm2[8], pm1[8];
#pragma unroll
        for (int e = 0; e < 8; ++e) { w0[e] = cw[ch0 + e]; w1[e] = cw[D + ch0 + e]; w2[e] = cw[2 * D + ch0 + e]; pm2[e] = 0.f; pm1[e] = 0.f; }
#pragma unroll
        for (int tt = -2; tt < 16; ++tt) {
            const int t = t0 + tt;
            float pr[8];
            if (t >= 0) { const bf16_t* row = P + ((size_t)b * SEQ + t) * 3072 + ch0;
                const u32x4 cg_ = *(const u32x4*)(row + 1024), xv = *(const u32x4*)(row + 2048);
#pragma unroll
                for (int e = 0; e < 4; ++e) { pr[2 * e] = bf2f(cg_[e] & 0xffffu) * bf2f(xv[e] & 0xffffu); pr[2 * e + 1] = bf2f(cg_[e] >> 16) * bf2f(xv[e] >> 16); }
            } else {
#pragma unroll
                for (int e = 0; e < 8; ++e) pr[e] = 0.f; }
            if (tt >= 0) { const bf16_t* row = P + ((size_t)b * SEQ + t) * 3072 + ch0; const u32x4 bg = *(const u32x4*)row; float ov[8];
#pragma unroll
                for (int e = 0; e < 4; ++e) { ov[2 * e] = bf2f(bg[e] & 0xffffu) * (w0[2 * e] * pm2[2 * e] + w1[2 * e] * pm1[2 * e] + w2[2 * e] * pr[2 * e]);
                    ov[2 * e + 1] = bf2f(bg[e] >> 16) * (w0[2 * e + 1] * pm2[2 * e + 1] + w1[2 * e + 1] * pm1[2 * e + 1] + w2[2 * e + 1] * pr[2 * e + 1]); }
                u32x4 o; o.x = pk2(ov[0], ov[1]); o.y = pk2(ov[2], ov[3]); o.z = pk2(ov[4], ov[5]); o.w = pk2(ov[6], ov[7]);
                *(u32x4*)(U + ((size_t)b * SEQ + t) * D + ch0) = o; }
#pragma unroll
            for (int e = 0; e < 8; ++e) { pm2[e] = pm1[e]; pm1[e] = pr[e]; }
        }
    }
}

constexpr int LR_XC = 0, LR_A = 36864, LR_B = 69632, LR_AGG = 102400, LR_CARRY = 106496, LR_CW = 106752;
__device__ __forceinline__ float gelu_tanh(float g) { const float u2 = 1.5957691216057308f * (g + 0.044715f * g * g * g); return g / (1.f + __expf(-u2)); }
__device__ __forceinline__ float neg_expm1(float x) {
    const float em = x * (1.f + x * (0.5f + x * (0.16666667f + x * (0.041666668f + x * 0.008333334f))));
    return (x < -0.25f) ? (1.f - __expf(x)) : -em; }
__device__ __forceinline__ float sigmoidf_(float z) { return 1.f / (1.f + __expf(-z)); }
__device__ __forceinline__ void lru_phase(const Params& p, LAS unsigned char* lds, int tid, int lane, int wave) {
    const bf16_t* P = (const bf16_t*)(p.ws + WS_P);
    bf16_t* U = (bf16_t*)(p.ws + WS_U);
    const int r32 = lane & 31, hi = lane >> 5;
    LAS float* LA = (LAS float*)(lds + LR_A); LAS float* LB = (LAS float*)(lds + LR_B);
    LAS float* AGG = (LAS float*)(lds + LR_AGG); LAS float* CARRY = (LAS float*)(lds + LR_CARRY); LAS float* CW = (LAS float*)(lds + LR_CW);
    for (int v = blockIdx.x; v < 256; v += gridDim.x) {
        const int b = v >> 5, n = (v >> 1) & 15, j = v & 1;
        const size_t rowbase = (size_t)b * SEQ;
        __syncthreads();
        if (tid < 256) CW[tid] = p.in[15][(tid >> 6) * D + 64 * n + (tid & 63)];
        else if (tid < 320) CW[tid] = p.in[16][64 * n + (tid - 256)];
        if (tid < 64) CARRY[tid] = 0.f;
        bf16x8 wfa[4], wfx[4];
        { const float* wa = p.in[17] + (size_t)n * 4096 + 32 * j + r32; const float* wx = p.in[19] + (size_t)n * 4096 + 32 * j + r32;
#pragma unroll
          for (int ks = 0; ks < 4; ++ks) { u32x4 ta, tx;
#pragma unroll
              for (int e = 0; e < 4; ++e) { const int k = 16 * ks + 8 * hi + 2 * e;
                  ta[e] = pk2(wa[(size_t)k * 64], wa[(size_t)(k + 1) * 64]); tx[e] = pk2(wx[(size_t)k * 64], wx[(size_t)(k + 1) * 64]); }
              wfa[ks] = __builtin_bit_cast(bf16x8, ta); wfx[ks] = __builtin_bit_cast(bf16x8, tx); } }
        const int chg = 64 * n + 32 * j + r32;
        const float ba = p.in[18][chg], bx = p.in[20][chg];
        float sp; { const float z = -p.in[21][chg]; sp = fmaxf(z, 0.f) + log1pf(__expf(-fabsf(z))); }
        __syncthreads();
        for (int sb = 0; sb < 8; ++sb) {
            const int t0 = sb * 256;
            { const int tl = tid >> 1, kh = tid & 1;
#pragma unroll 1
              for (int c8 = 0; c8 < 4; ++c8) { const int kc = 32 * kh + 8 * c8; float acc[8];
#pragma unroll
                  for (int e = 0; e < 8; ++e) acc[e] = CW[256 + kc + e];
#pragma unroll
                  for (int jj = 0; jj < 4; ++jj) { const int t = t0 + tl - 3 + jj;
                      if (t >= 0) { const u32x4 xv = *(const u32x4*)(P + (rowbase + t) * 2048 + 1024 + 64 * n + kc);
#pragma unroll
                          for (int e = 0; e < 4; ++e) { acc[2 * e] += CW[jj * 64 + kc + 2 * e] * bf2f(xv[e] & 0xffffu); acc[2 * e + 1] += CW[jj * 64 + kc + 2 * e + 1] * bf2f(xv[e] >> 16); } } }
                  u32x4 o; o.x = pk2(acc[0], acc[1]); o.y = pk2(acc[2], acc[3]); o.z = pk2(acc[4], acc[5]); o.w = pk2(acc[6], acc[7]);
                  *(LAS u32x4*)(lds + LR_XC + tl * 144 + kc * 2) = o; } }
            __syncthreads();
            { f32x16 ra, rx;
#pragma unroll
              for (int r = 0; r < 16; ++r) { ra[r] = 0.f; rx[r] = 0.f; }
#pragma unroll
              for (int ks = 0; ks < 4; ++ks) { const bf16x8 af = *(const LAS bf16x8*)(lds + LR_XC + (32 * wave + r32) * 144 + (16 * ks + 8 * hi) * 2);
                  ra = __builtin_amdgcn_mfma_f32_32x32x16_bf16(af, wfa[ks], ra, 0, 0, 0);
                  rx = __builtin_amdgcn_mfma_f32_32x32x16_bf16(af, wfx[ks], rx, 0, 0, 0); }
#pragma unroll
              for (int r = 0; r < 16; ++r) { const int tl = 32 * wave + crow(r, hi);
                  const float xc = bf2f(*(const LAS bf16_t*)(lds + LR_XC + tl * 144 + (32 * j + r32) * 2));
                  const float rg = sigmoidf_(ra[r] + ba), ig = sigmoidf_(rx[r] + bx);
                  const float la = -8.0f * rg * sp, a = __expf(la), mult = sqrtf(neg_expm1(2.0f * la));
                  LA[tl * 32 + r32] = a; LB[tl * 32 + r32] = mult * ig * xc; } }
            __syncthreads();
            { const int ch = tid & 31, tc = tid >> 5;
              float Aa = 1.f, Bv = 0.f;
#pragma unroll 4
              for (int i = 0; i < 16; ++i) { const float a = LA[(16 * tc + i) * 32 + ch], bb = LB[(16 * tc + i) * 32 + ch]; Bv = a * Bv + bb; Aa *= a; }
              AGG[tc * 64 + ch] = Aa; AGG[tc * 64 + 32 + ch] = Bv;
              __syncthreads();
              float hst = CARRY[(sb & 1) * 32 + ch];
              for (int c = 0; c < tc; ++c) hst = AGG[c * 64 + ch] * hst + AGG[c * 64 + 32 + ch];
#pragma unroll 4
              for (int i = 0; i < 16; ++i) { const int tl = 16 * tc + i; hst = LA[tl * 32 + ch] * hst + LB[tl * 32 + ch];
                  const float g = bf2f(P[(rowbase + t0 + tl) * 2048 + 64 * n + 32 * j + ch]);
                  U[(rowbase + t0 + tl) * D + 64 * n + 32 * j + ch] = (bf16_t)f2bf(hst * gelu_tanh(g)); }
              if (tc == 15) CARRY[((sb + 1) & 1) * 32 + ch] = hst; }
            __syncthreads();
        }
    }
}

#define XB_TMO      128
#define XB_XCNT(j)  (256  + 64 * (j))
#define XB_XSUB(j)  (1280 + 64 * (j))
#define XB_XGEN(j)  (2304 + 64 * (j))
#define XB_TOP      3328
#define XB_TOPGEN   3392
#define XCD_BAR_WORDS 3456
#define XB_SPIN_CAP (1u << 18)

__device__ __forceinline__ unsigned xb_ld(unsigned* p)              { return __hip_atomic_load(p, __ATOMIC_RELAXED, __HIP_MEMORY_SCOPE_AGENT); }
__device__ __forceinline__ unsigned xb_add(unsigned* p, unsigned v) { return __hip_atomic_fetch_add(p, v, __ATOMIC_RELAXED, __HIP_MEMORY_SCOPE_AGENT); }
__device__ __forceinline__ unsigned xb_xcc_id() { return (unsigned)__builtin_amdgcn_s_getreg((3 << 11) | 20) & 0xFu; }
#define XB_SPIN(cond, bar) do { unsigned _sp = 0; while (cond) { __builtin_amdgcn_s_sleep(1); \
    if ((++_sp & 255u) == 0u) { if (xb_ld(&(bar)[XB_TMO])) break; if (_sp > XB_SPIN_CAP) { atomicAdd(&(bar)[XB_TMO], 1u); break; } } } } while (0)

struct XcdBarrier {
    unsigned* bar; unsigned x;
    volatile LAS unsigned* st;
};

__device__ __forceinline__ XcdBarrier xcd_barrier_post(unsigned* bar, volatile LAS unsigned* st) {
    XcdBarrier b; b.bar = bar; b.x = xb_xcc_id(); b.st = st;
    if (threadIdx.x == 0) (void)xb_add(&bar[XB_XCNT(b.x)], 1u);
    return b;
}
__device__ __forceinline__ void xcd_barrier_complete(unsigned* bar, unsigned x, unsigned& nloc, unsigned& nx) {
    const unsigned G = gridDim.x * gridDim.y * gridDim.z;
    unsigned sum, cnt, mine, sp = 0u;
    for (;;) {
        sum = 0u; cnt = 0u; mine = 0u;
#pragma unroll
        for (unsigned j = 0; j < 16; ++j) { const unsigned c = xb_ld(&bar[XB_XCNT(j)]); sum += c; cnt += (c > 0u) ? 1u : 0u; mine = (j == x) ? c : mine; }
        if (sum == G) break;
        __builtin_amdgcn_s_sleep(1);
        if ((++sp & 255u) == 0u) { if (xb_ld(&bar[XB_TMO])) break; if (sp > XB_SPIN_CAP) { atomicAdd(&bar[XB_TMO], 1u); break; } }
    }
    nloc = mine > 0u ? mine : 1u; nx = cnt > 0u ? cnt : 1u;
}

__device__ __forceinline__ void xcd_barrier(const XcdBarrier& b) {
    asm volatile("s_waitcnt vmcnt(0)" ::: "memory");
    __syncthreads();
    if (threadIdx.x == 0) {
        unsigned* bar = b.bar;
        __builtin_amdgcn_s_waitcnt(0);
        unsigned nloc = b.st[0], nx = b.st[1];
        if (nloc == 0u) { xcd_barrier_complete(bar, b.x, nloc, nx); b.st[0] = nloc; b.st[1] = nx; }
        const unsigned old = xb_add(&bar[XB_XSUB(b.x)], 1u);
        const unsigned gen = old / nloc;
        if (old + 1u == (gen + 1u) * nloc) {
            __builtin_amdgcn_fence(__ATOMIC_RELEASE, "agent");
            asm volatile("s_waitcnt vmcnt(0)" ::: "memory");
            const unsigned og = xb_add(&bar[XB_TOP], 1u);
            const unsigned tg = og / nx;
            if (og + 1u == (tg + 1u) * nx) xb_add(&bar[XB_TOPGEN], 1u);
            else XB_SPIN(xb_ld(&bar[XB_TOPGEN]) == tg, bar);
            __builtin_amdgcn_fence(__ATOMIC_ACQUIRE, "agent");
            xb_add(&bar[XB_XGEN(b.x)], 1u);
            asm volatile("s_waitcnt vmcnt(0)" ::: "memory");
        } else {
            XB_SPIN(xb_ld(&bar[XB_XGEN(b.x)]) == gen, bar);
            __builtin_amdgcn_fence(__ATOMIC_ACQUIRE, "agent");
            asm volatile("s_waitcnt vmcnt(0)" ::: "memory");
        }
    }
    __syncthreads();
}

__global__ void __launch_bounds__(NTHR, 2) fwd_megakernel(Params p) {
    extern __shared__ __attribute__((aligned(16))) unsigned char lds_raw[];
    LAS unsigned char* lds = (LAS unsigned char*)lds_raw;
    cg::grid_group grid = cg::this_grid();
    const int tid0 = threadIdx.x, wave = __builtin_amdgcn_readfirstlane(tid0 >> 6);
    unsigned char* ws = p.ws;
    bf16_t* XN = (bf16_t*)(ws + WS_XN); bf16_t* Ub = (bf16_t*)(ws + WS_U); bf16_t* Pb = (bf16_t*)(ws + WS_P);
    float* Y = (float*)(ws + WS_Y); float* FL = (float*)(ws + WS_FL);
    if (tid0 < 16) ((LAS unsigned*)(lds + LDS_BARST))[tid0] = 0u;
    __syncthreads();
    XcdBarrier bar = xcd_barrier_post((unsigned*)(ws + WS_BAR), (volatile LAS unsigned*)(lds + LDS_BARST));
    for (int ph = p.ph_lo; ph < p.ph_hi; ++ph) {
        int tid = tid0; asm volatile("" : "+v"(tid));
        const int lane = tid & 63;
        if (ph == 0) prologue_phase(p, lds, tid, lane, wave);
        else if (ph == NPH - 1) thin_phase(p, 3, 2, -1, 0, p.out, lane, wave);
        else {
            const int i = (ph - 1) / 10, k = (ph - 1) % 10, kind = i % 3, jm = i / 3;
            if (k == 0) { if (i == 0) thin_phase(p, -1, 0, 0, 0, p.in[0], lane, wave); else thin_phase(p, i - 1, 2, i, 0, p.out, lane, wave); }
            else if (k == 3) thin_phase(p, i, 0, i, 1, p.out, lane, wave);
            else if (k == 7) thin_phase(p, i, 1, i, 2, p.out, lane, wave);
            else if (k == 1 || k == 8) { const int s = (k == 1) ? 0 : 1;
                pg8::Gemm g{XN, (const bf16_t*)(ws + WS_WFI) + (size_t)(i * 2 + s) * 2 * FF * D, M, 2 * FF, D}; pg8::StaticOrder S; S.init(M, 2 * FF, (int)gridDim.x, (int)blockIdx.x);
                pg8::EpiSwiglu E{Pb, FF}; pg8::gemm_phase<pg8::EpiSwiglu, pg8::StaticOrder, true, true>(lds, g, S, E); }
            else if (k == 2 || k == 9) { const int s = (k == 2) ? 0 : 1;
                pg8::Gemm g{Pb, (const bf16_t*)(ws + WS_WFO) + (size_t)(i * 2 + s) * D * FF, M, D, FF}; pg8::StaticOrder S; S.init(M, D, (int)gridDim.x, (int)blockIdx.x);
                pg8::EpiF32 E{Y, D}; pg8::gemm_phase<pg8::EpiF32, pg8::StaticOrder, true, true>(lds, g, S, E); }
            else if (k == 4) {
                const bf16_t* W = (kind == 0) ? (const bf16_t*)(ws + WS_FOXI) + (size_t)jm * 3328 * D : (kind == 1) ? (const bf16_t*)(ws + WS_SCI) : (const bf16_t*)(ws + WS_LRI);
                const int N = (kind == 0) ? 3328 : (kind == 1) ? 3072 : 2048, ldp = (kind == 2) ? 2048 : 3072;
                pg8::Gemm g{XN, W, M, N, D}; pg8::StaticOrder S; S.init(M, N, (int)gridDim.x, (int)blockIdx.x);
                pg8::EpiProj E{Pb, ldp, ldp, FL}; pg8::gemm_phase<pg8::EpiProj, pg8::StaticOrder, true, true>(lds, g, S, E); }
            else if (k == 5) {
                if (kind == 0) attn_phase(p, jm, lds, tid, lane, wave);
                else if (kind == 1) sconv_phase(p, tid);
                else lru_phase(p, lds, tid, lane, wave); }
            else {
                const bf16_t* W = (kind == 0) ? (const bf16_t*)(ws + WS_FOXO) + (size_t)jm * D * D : (kind == 1) ? (const bf16_t*)(ws + WS_SCO) : (const bf16_t*)(ws + WS_LRO);
                pg8::Gemm g{Ub, W, M, D, D}; pg8::StaticOrder S; S.init(M, D, (int)gridDim.x, (int)blockIdx.x);
                pg8::EpiF32 E{Y, D}; pg8::gemm_phase<pg8::EpiF32, pg8::StaticOrder, true, true>(lds, g, S, E); }
        }
        if (ph + 1 < p.ph_hi) { if (ph == 0) grid.sync(); else xcd_barrier(bar); }
    }
}

extern "C" void kernel_launch(void* const* d_in, const int* in_sizes, int n_in, void* d_out, int out_size, void* d_ws, size_t ws_size, hipStream_t stream) {
    static int grid = 0;
    if (grid == 0) {
        if (n_in != 23 || out_size != M * D || ws_size < WS_END) { fprintf(stderr, "kernel_launch: unexpected problem (n_in %d out %d ws %zu)\n", n_in, out_size, ws_size); grid = -1; return; }
        int dev = 0, cus = 0, per_cu = 0;
        hipGetDevice(&dev); hipDeviceGetAttribute(&cus, hipDeviceAttributeMultiprocessorCount, dev);
        hipFuncSetAttribute((const void*)fwd_megakernel, hipFuncAttributeMaxDynamicSharedMemorySize, LDS_BYTES);
        hipOccupancyMaxActiveBlocksPerMultiprocessor(&per_cu, (const void*)fwd_megakernel, NTHR, LDS_BYTES);
        if (per_cu < 1) per_cu = 1;
        (void)hipGetLastError();
        grid = cus;
        if (grid > 256) grid = 256;
    }
    if (grid < 0) return;
    Params p{};
    for (int i = 0; i < 23; ++i) p.in[i] = (const float*)d_in[i];
    p.out = (float*)d_out; p.ws = (unsigned char*)d_ws; p.ph_lo = 0; p.ph_hi = NPH;
    (void)hipMemsetAsync((unsigned char*)d_ws + WS_BAR, 0, 16384, stream);
    void* args[] = {&p};
    hipError_t e = hipLaunchCooperativeKernel((const void*)fwd_megakernel, dim3(grid), dim3(NTHR), args, LDS_BYTES, stream);
    if (e != hipSuccess) fprintf(stderr, "cooperative launch failed: %s (grid %d)\n", hipGetErrorString(e), grid);
}
```
